# Optimizing an MI355X kernel written in HIP

```python
import functools
import jax, jax.numpy as jnp
from jax import lax
import numpy as np

D_MODEL = 1024
BATCH = 8
SEQ = 2048
DEPTH = 2
DEC_BATCH = 128
DEC_SEQ = 1
PAST_LEN = 16384
PAGE_SIZE = 128

M_HEADS = 4
M_WIDTH = 3 * D_MODEL // 8
M_DH = M_WIDTH // M_HEADS
R_HEADS = 4
R_WIDTH = 3 * D_MODEL // 8
R_DH = R_WIDTH // R_HEADS
H_HEADS = 4
H_WIDTH = D_MODEL // 4
H_DK = H_WIDTH // H_HEADS
H_DV = H_WIDTH // H_HEADS
D_MIX = M_WIDTH + R_WIDTH + H_WIDTH
CONV_W = 4
CHUNK = 64
ROPE_BASE = 10000.0
LN_EPS = 1e-5
HEAD_EPS = 1e-6
ALPHA = (2 * DEPTH) ** 0.25
BETA = (8 * DEPTH) ** -0.25
N_IN = 5 * M_WIDTH + 2 * M_HEADS + 4 * R_WIDTH + 4 * H_WIDTH

kernel_name = "hybrid_mlstm_retention_hgrn2_step"


def _split_points():
    sizes = [2 * M_WIDTH, M_WIDTH, M_WIDTH, M_WIDTH, 2 * M_HEADS,
             R_WIDTH, R_WIDTH, R_WIDTH, R_WIDTH,
             H_WIDTH, H_WIDTH, H_WIDTH, H_WIDTH]
    points, acc = [], 0
    for s in sizes[:-1]:
        acc += s
        points.append(acc)
    return points


def layer_norm(x, g, b):
    x32 = x.astype(jnp.float32)
    mu = jnp.mean(x32, -1, keepdims=True)
    var = jnp.mean(jnp.square(x32 - mu), -1, keepdims=True)
    y = (x32 - mu) * lax.rsqrt(var + LN_EPS) * g.astype(jnp.float32) + b.astype(jnp.float32)
    return y.astype(x.dtype)


def head_layer_norm(h, w):
    mu = jnp.mean(h, -1, keepdims=True)
    var = jnp.mean(jnp.square(h - mu), -1, keepdims=True)
    hn = (h - mu) * lax.rsqrt(var + HEAD_EPS)
    return hn.reshape(h.shape[0], h.shape[1], -1) * w.astype(jnp.float32)


def head_rms_norm(h, w):
    hn = h * lax.rsqrt(jnp.mean(jnp.square(h), -1, keepdims=True) + HEAD_EPS)
    return hn.reshape(h.shape[0], h.shape[1], -1) * w.astype(jnp.float32)


def causal_conv(x, buf, w, b):
    T = x.shape[1]
    xp = jnp.concatenate([buf.astype(x.dtype), x], axis=1)
    out = b.astype(x.dtype)
    for j in range(CONV_W):
        out = out + w[j].astype(x.dtype) * xp[:, j:j + T]
    return out, xp[:, xp.shape[1] - (CONV_W - 1):]


def rope(x, pos):
    half = x.shape[-1] // 2
    inv = ROPE_BASE ** (-jnp.arange(half, dtype=jnp.float32) / half)
    ang = pos.astype(jnp.float32)[:, None] * inv[None, :]
    cos = jnp.cos(ang)[None, :, None, :]
    sin = jnp.sin(ang)[None, :, None, :]
    x1, x2 = x[..., :half], x[..., half:]
    return jnp.concatenate([x1 * cos - x2 * sin, x1 * sin + x2 * cos], axis=-1)


def run_chunked(step, carry, xs, T):
    L = CHUNK if T % CHUNK == 0 else T
    n = T // L
    xs_c = tuple(jnp.moveaxis(a.reshape(a.shape[0], n, L, *a.shape[2:]), 1, 0) for a in xs)
    carry, ys = lax.scan(step, carry, xs_c)
    ys = jnp.moveaxis(ys, 0, 1)
    return carry, ys.reshape(ys.shape[0], T, *ys.shape[3:])


def mlstm_step(carry, inp):
    C, n, m = carry
    q, k, v, ig, lf = inp
    L = q.shape[1]
    b = jnp.swapaxes(jnp.cumsum(lf, axis=1), 1, 2)
    igT = jnp.swapaxes(ig, 1, 2)
    mask = jnp.tril(jnp.ones((L, L), dtype=bool))
    logD = jnp.where(mask, b[..., :, None] - b[..., None, :] + igT[..., None, :], -jnp.inf)
    prior = b + m[..., None]
    m_t = jnp.maximum(jnp.max(logD, axis=-1), prior)
    s = jnp.einsum('blhd,bshd->bhls', q, k) * jnp.exp(logD - m_t[..., None])
    w_prior = jnp.exp(prior - m_t)
    num = (jnp.einsum('bhls,bshd->blhd', s, v)
           + jnp.einsum('blhk,bhkv->blhv', q, C) * jnp.swapaxes(w_prior, 1, 2)[..., None])
    den = jnp.sum(s, axis=-1) + jnp.einsum('blhk,bhk->bhl', q, n) * w_prior
    denom = jnp.maximum(jnp.abs(den), jnp.exp(-m_t))
    h = num / jnp.swapaxes(denom, 1, 2)[..., None]
    m_new = m_t[..., -1]
    dec = jnp.exp(b[..., -1] + m - m_new)
    w_s = jnp.exp(b[..., -1:] - b + igT - m_new[..., None])
    C_new = dec[..., None, None] * C + jnp.einsum('bhs,bshk,bshv->bhkv', w_s, k, v)
    n_new = dec[..., None] * n + jnp.einsum('bhs,bshk->bhk', w_s, k)
    return (C_new, n_new, m_new), h


def ret_step(lg, R, inp):
    q, k, v = inp
    L = q.shape[1]
    idx = jnp.arange(L, dtype=jnp.float32)
    mask = jnp.tril(jnp.ones((L, L), dtype=bool))
    diff = jnp.where(mask, idx[:, None] - idx[None, :], 0.0)
    D = jnp.where(mask[None], jnp.exp(diff[None] * lg[:, None, None]), 0.0)
    s = jnp.einsum('blhd,bshd->bhls', q, k) * D[None]
    intra = jnp.einsum('bhls,bshv->blhv', s, v)
    inter = jnp.einsum('blhk,bhkv->blhv', q, R) * jnp.exp((idx[:, None] + 1.0) * lg[None, :])[None, :, :, None]
    k_dec = k * jnp.exp((L - 1.0 - idx)[:, None] * lg[None, :])[None, :, :, None]
    R_new = jnp.exp(L * lg)[None, :, None, None] * R + jnp.einsum('bshk,bshv->bhkv', k_dec, v)
    return R_new, intra + inter


def hgrn_step(S, inp):
    q, k, v, lf = inp
    L = q.shape[1]
    Bc = jnp.cumsum(lf, axis=1)
    mask = jnp.tril(jnp.ones((L, L), dtype=bool))[None, :, :, None, None]
    diff = jnp.where(mask, Bc[:, :, None] - Bc[:, None, :], 0.0)
    D = jnp.where(mask, jnp.exp(diff), 0.0)
    s = jnp.einsum('bthk,bshk,btshk->bhts', q, k, D)
    intra = jnp.einsum('bhts,bshv->bthv', s, v)
    inter = jnp.einsum('bthk,bhkv->bthv', q * jnp.exp(Bc), S)
    S_new = (jnp.exp(Bc[:, -1])[..., None] * S
             + jnp.einsum('bshk,bshv->bhkv', k * jnp.exp(Bc[:, -1:] - Bc), v))
    return S_new, intra + inter


def hybrid_layer(x, pos, st, w_in, conv_w, conv_b, b_mgate, m_norm_w, r_norm_w, h_norm_w, lb, w_out, ln_g, ln_b):
    f32 = jnp.float32
    C0, n0, m0, buf0, R0, S0 = st
    Bsz, T = x.shape[0], x.shape[1]
    proj = jnp.einsum('btd,dn->btn', x, w_in)
    (m_qk, m_v, m_o, m_z, m_if, r_q, r_k, r_v, r_g,
     h_f, h_i, h_q, h_g) = jnp.split(proj, _split_points(), axis=-1)

    def heads(a, H):
        return a.reshape(Bsz, T, H, -1).astype(f32)

    qk, buf_new = causal_conv(m_qk, buf0, conv_w, conv_b)
    qk = jax.nn.silu(qk)
    q_m, k_m = jnp.split(qk, 2, axis=-1)
    q_m = heads(q_m, M_HEADS)
    k_m = heads(k_m, M_HEADS) * (M_DH ** -0.5)
    v_m = heads(m_v, M_HEADS)
    gates = (m_if + b_mgate).astype(f32)
    ig = gates[..., :M_HEADS]
    lf_m = jax.nn.log_sigmoid(gates[..., M_HEADS:])
    (C1, n1, m1), h_m = run_chunked(
        mlstm_step, (C0.astype(f32), n0.astype(f32), m0.astype(f32)), (q_m, k_m, v_m, ig, lf_m), T)
    y_m = head_layer_norm(h_m, m_norm_w) * jax.nn.sigmoid(m_o.astype(f32)) * jax.nn.silu(m_z.astype(f32))

    q_r = rope(heads(r_q, R_HEADS), pos)
    k_r = rope(heads(r_k, R_HEADS), pos) * (R_DH ** -0.5)
    v_r = heads(r_v, R_HEADS)
    lg = jnp.log1p(-jnp.exp2(-5.0 - jnp.arange(R_HEADS, dtype=f32)))
    R1, h_r = run_chunked(functools.partial(ret_step, lg), R0.astype(f32), (q_r, k_r, v_r), T)
    y_r = head_layer_norm(h_r, r_norm_w) * jax.nn.silu(r_g.astype(f32))

    fpre = heads(h_f, H_HEADS)
    lbh = lb.reshape(H_HEADS, H_DK)
    lf_h = jnp.logaddexp(jnp.log(lbh), jnp.log1p(-lbh) + jax.nn.log_sigmoid(fpre))
    k_h = (1.0 - lbh) * jax.nn.sigmoid(-fpre)
    S1, h_h = run_chunked(hgrn_step, S0.astype(f32), (heads(h_q, H_HEADS), k_h, heads(h_i, H_HEADS), lf_h), T)
    y_h = head_rms_norm(h_h, h_norm_w) * jax.nn.silu(h_g.astype(f32))

    mix = jnp.concatenate([y_m, y_r, y_h], axis=-1).astype(x.dtype)
    out = jnp.einsum('btm,md->btd', mix, w_out)
    x_new = layer_norm(ALPHA * x + out, ln_g, ln_b)
    return x_new, (C1, n1, m1, buf_new, R1, S1)


def _zero_state(Bsz, dtype):
    f32 = jnp.float32
    return (jnp.zeros((Bsz, M_HEADS, M_DH, M_DH), f32),
            jnp.zeros((Bsz, M_HEADS, M_DH), f32),
            jnp.zeros((Bsz, M_HEADS), f32),
            jnp.zeros((Bsz, CONV_W - 1, 2 * M_WIDTH), dtype),
            jnp.zeros((Bsz, R_HEADS, R_DH, R_DH), f32),
            jnp.zeros((Bsz, H_HEADS, H_DK, H_DV), f32))


def setup_inputs(seed: int = 0) -> dict:
    key = jax.random.key(seed)
    ks = jax.random.split(key, 20)
    nrm = jax.random.normal
    f_bias = jnp.linspace(3.0, 6.0, M_HEADS, dtype=jnp.float32)[None, :] + 0.1 * nrm(ks[10], (DEPTH, M_HEADS))
    i_bias = 0.1 * nrm(ks[11], (DEPTH, M_HEADS))
    return {
        "x_prompt": nrm(ks[0], (BATCH, SEQ, D_MODEL), jnp.float32),
        "x_sample": nrm(ks[1], (DEC_BATCH, DEC_SEQ, D_MODEL), jnp.float32),
        "state_mlstm_C": 0.3 * nrm(ks[2], (DEPTH, DEC_BATCH, M_HEADS, M_DH, M_DH), jnp.float32),
        "state_mlstm_n": 0.3 * nrm(ks[3], (DEPTH, DEC_BATCH, M_HEADS, M_DH), jnp.float32),
        "state_mlstm_m": nrm(ks[4], (DEPTH, DEC_BATCH, M_HEADS), jnp.float32),
        "state_mlstm_conv": nrm(ks[5], (DEPTH, DEC_BATCH, CONV_W - 1, 2 * M_WIDTH), jnp.float32),
        "state_ret": 0.5 * nrm(ks[6], (DEPTH, DEC_BATCH, R_HEADS, R_DH, R_DH), jnp.float32),
        "state_hgrn": 0.5 * nrm(ks[7], (DEPTH, DEC_BATCH, H_HEADS, H_DK, H_DV), jnp.float32),
        "w_in": nrm(ks[8], (DEPTH, D_MODEL, N_IN), jnp.float32) * D_MODEL ** -0.5,
        "conv_w": nrm(ks[9], (DEPTH, CONV_W, 2 * M_WIDTH), jnp.float32) * CONV_W ** -0.5,
        "conv_b": 0.01 * nrm(ks[12], (DEPTH, 2 * M_WIDTH), jnp.float32),
        "b_mgate": jnp.concatenate([i_bias, f_bias], axis=-1),
        "m_norm_w": 1.0 + 0.02 * nrm(ks[13], (DEPTH, M_WIDTH), jnp.float32),
        "r_norm_w": 1.0 + 0.02 * nrm(ks[14], (DEPTH, R_WIDTH), jnp.float32),
        "h_norm_w": 1.0 + 0.02 * nrm(ks[15], (DEPTH, H_WIDTH), jnp.float32),
        "hgrn_lb": nrm(ks[16], (DEPTH, H_WIDTH), jnp.float32),
        "w_out": nrm(ks[17], (DEPTH, D_MIX, D_MODEL), jnp.float32) * (D_MIX ** -0.5) * BETA,
        "ln_g": 1.0 + 0.02 * nrm(ks[18], (DEPTH, D_MODEL), jnp.float32),
        "ln_b": 0.01 * nrm(ks[19], (DEPTH, D_MODEL), jnp.float32),
    }


def reference(x_prompt, x_sample, state_mlstm_C, state_mlstm_n, state_mlstm_m, state_mlstm_conv,
              state_ret, state_hgrn, w_in, conv_w, conv_b, b_mgate, m_norm_w, r_norm_w, h_norm_w,
              hgrn_lb, w_out, ln_g, ln_b):
    T_p = x_prompt.shape[1]
    T_s = x_sample.shape[1]
    pos_p = jnp.arange(T_p, dtype=jnp.int32)
    pos_s = PAST_LEN + jnp.arange(T_s, dtype=jnp.int32)
    lb_all = jnp.cumsum(jax.nn.softmax(hgrn_lb.astype(jnp.float32), axis=0), axis=0)
    lb_all = lb_all - lb_all[0:1]
    hp, hs = x_prompt, x_sample
    new_p = [[] for _ in range(6)]
    new_s = [[] for _ in range(6)]
    for l in range(DEPTH):
        params = (w_in[l], conv_w[l], conv_b[l], b_mgate[l], m_norm_w[l], r_norm_w[l], h_norm_w[l],
                  lb_all[l], w_out[l], ln_g[l], ln_b[l])
        st_p = _zero_state(x_prompt.shape[0], x_prompt.dtype)
        st_s = (state_mlstm_C[l], state_mlstm_n[l], state_mlstm_m[l], state_mlstm_conv[l],
                state_ret[l], state_hgrn[l])
        hp, sp = hybrid_layer(hp, pos_p, st_p, *params)
        hs, ss = hybrid_layer(hs, pos_s, st_s, *params)
        for j in range(6):
            new_p[j].append(sp[j])
            new_s[j].append(ss[j])
    mC_p, mn_p, mm_p, conv_p, ret_p, hgrn_p = [jnp.stack(a) for a in new_p]
    mC_s, mn_s, mm_s, conv_s, ret_s, hgrn_s = [jnp.stack(a) for a in new_s]
    return (hp, hs, mC_p, mn_p, mm_p, conv_p, ret_p, hgrn_p, mC_s, mn_s, mm_s, conv_s, ret_s, hgrn_s)
```

```cpp
#include <hip/hip_runtime.h>
#include <hip/hip_cooperative_groups.h>
#include <cstdio>
namespace pg8 {
#define PG8_LAS __attribute__((address_space(3)))
typedef unsigned short bf16_t;
typedef short bf16x8 __attribute__((ext_vector_type(8)));
typedef float f32x4 __attribute__((ext_vector_type(4)));
typedef unsigned u32x4 __attribute__((ext_vector_type(4)));
constexpr int BM = 256, BK = 64, HALF = 128, HTB = HALF * BK * 2  , STAGE_BYTES = 8 * HTB, NXCD = 8, WGM = 8;


__device__ __forceinline__ int ltid() { int t = threadIdx.x; asm volatile("" : "+v"(t)); return t; }
__host__ __device__ __forceinline__ int lds_byte(int r, int c) { const int st = (r >> 4) * 2 + (c >> 5), rr = r & 15, cc = c & 31, ob = rr * 64 + cc * 2; return st * 1024 + (ob ^ (((ob >> 9) & 1) << 5)); }
__host__ __device__ __forceinline__ void stage_rc(int b, int& R, int& C) { const int st = b / 1024, sb = b % 1024, swz = sb ^ (((sb >> 9) & 1) << 5); R = (st >> 1) * 16 + swz / 64; C = (st & 1) * 32 + (swz % 64) / 2; }
__host__ __device__ __forceinline__ int perm32(int rho) { const int n = rho >> 4, i = rho & 15; return 8 * (i >> 2) + 4 * n + (i & 3); }

struct Unit { int pm, pn; };
struct Gemm { const bf16_t* A; const bf16_t* Bt; int M, N, K; };
struct StaticOrder {
    int nM, nN, nwg, G, c;
    __host__ __device__ void init(int M, int N, int G_, int c_) { nM = M / BM; nN = N / BM; nwg = nM * nN; G = G_; c = c_; }
    __host__ __device__ bool next(int i, Unit& u) const {
        const long L = (long)i * G + c; if (L >= nwg) return false;
        int wgid = (int)L; { const int q = nwg / NXCD, r = nwg % NXCD, xcd = wgid % NXCD, off = wgid / NXCD; wgid = (xcd < r ? xcd * (q + 1) : r * (q + 1) + (xcd - r) * q) + off; }
        const int nig = WGM * nN, gid = wgid / nig, fm = gid * WGM, gsz = (nM - fm) < WGM ? (nM - fm) : WGM;
        u.pm = fm + ((wgid % nig) % gsz); u.pn = (wgid % nig) / gsz; return true;
    }
    __device__ __forceinline__ void a_ready(const Unit&) const {}
    __device__ __forceinline__ void done(const Unit&) const {}
};

template <class Epi, class Sched>
__device__ __forceinline__ void gemm_phase(PG8_LAS unsigned char* lds, const Gemm g, const Sched& S, const Epi& E) {
    const int tid = ltid(), wid = __builtin_amdgcn_readfirstlane(tid >> 6), lane = tid & 63, wr = wid >> 2, wc = wid & 3, fr = lane & 15, fq = lane >> 4;
    const int K = g.K, nt = K / BK;
    unsigned voffA[2], voffB[2];
#pragma unroll
    for (int i = 0; i < 2; ++i) { int R, C; stage_rc(tid * 16 + i * 8192, R, C); const int Rb = Epi::PERM ? ((R & ~31) + perm32(R & 31)) : R;
        voffA[i] = (unsigned)(R * K + C) * 2u; voffB[i] = (unsigned)(Rb * K + C) * 2u; }
    const size_t kstep = (size_t)(BK * 2);
    const size_t hstep = (size_t)HALF * K * 2;
    const size_t tstep = 2 * hstep;
    const unsigned ldsw = (unsigned)wid * 1024u;
    const int aoff = lds_byte(wr * 64 + fr, fq * 8), boff = lds_byte(wc * 32 + fr, fq * 8);
#define PG8_SA(b, h) (((b) * 2 + (h)) * HTB)
#define PG8_SB(b, h) ((4 + (b) * 2 + (h)) * HTB)
#define PG8_STAGE(bufoff, gbase, voff) do { _Pragma("unroll") for (int _i = 0; _i < 2; ++_i) \
        __builtin_amdgcn_global_load_lds((const unsigned*)((const char*)(gbase) + (voff)[_i]), (PG8_LAS unsigned*)(lds + (bufoff) + ldsw + _i * 8192), 16, 0, 0); } while (0)
#define PG8_LDA(dst, b, h) do { _Pragma("unroll") for (int m = 0; m < 4; ++m) _Pragma("unroll") for (int k = 0; k < 2; ++k) dst[m][k] = *(const PG8_LAS bf16x8*)(lds + PG8_SA(b, h) + aoff + m * 2048 + k * 1024); } while (0)
#define PG8_LDB(dst, b, h) do { _Pragma("unroll") for (int n = 0; n < 2; ++n) _Pragma("unroll") for (int k = 0; k < 2; ++k) dst[n][k] = *(const PG8_LAS bf16x8*)(lds + PG8_SB(b, h) + boff + n * 2048 + k * 1024); } while (0)
#define PG8_MMA(ai, bj, At, Bt) do { __builtin_amdgcn_s_setprio(1); _Pragma("unroll") for (int m = 0; m < 4; ++m) _Pragma("unroll") for (int n = 0; n < 2; ++n) _Pragma("unroll") for (int k = 0; k < 2; ++k) \
        acc[ai][bj][m][n] = __builtin_amdgcn_mfma_f32_16x16x32_bf16(Bt[n][k], At[m][k], acc[ai][bj][m][n], 0, 0, 0); __builtin_amdgcn_s_setprio(0); } while (0)
#define PG8_WAIT_V(n) asm volatile("s_waitcnt vmcnt(" #n ")" ::: "memory")
#define PG8_WAIT_L(n) asm volatile("s_waitcnt lgkmcnt(" #n ")" ::: "memory")
#define PG8_BAR __builtin_amdgcn_s_barrier()
#define PG8_SCHED __builtin_amdgcn_sched_barrier(0)
    Unit cur, nxt; int ui = 0;
    if (!S.next(0, cur)) return;
    f32x4 acc[2][2][4][2];
#pragma unroll
    for (int a = 0; a < 2; ++a)
#pragma unroll
        for (int b = 0; b < 2; ++b)
#pragma unroll
            for (int m = 0; m < 4; ++m)
#pragma unroll
                for (int n = 0; n < 2; ++n) acc[a][b][m][n] = (f32x4){0.f, 0.f, 0.f, 0.f};
    bf16x8 At[4][2], B0[2][2], B1[2][2];
    const char* cA = (const char*)g.A + (size_t)cur.pm * tstep; const char* cB = (const char*)g.Bt + (size_t)cur.pn * tstep;
    S.a_ready(cur);
    PG8_STAGE(PG8_SB(0, 0), cB, voffB); PG8_STAGE(PG8_SA(0, 0), cA, voffA); PG8_STAGE(PG8_SB(0, 1), cB + hstep, voffB); PG8_STAGE(PG8_SA(0, 1), cA + hstep, voffA);
    if (wr == 1) PG8_BAR;
    PG8_WAIT_V(4); PG8_BAR;
    PG8_STAGE(PG8_SB(1, 0), cB + kstep, voffB); PG8_STAGE(PG8_SA(1, 0), cA + kstep, voffA); PG8_STAGE(PG8_SB(1, 1), cB + hstep + kstep, voffB);
    PG8_WAIT_V(6); PG8_BAR;
    for (;;) {
        const bool has_next = S.next(ui + 1, nxt);
        const char* nA = has_next ? (const char*)g.A + (size_t)nxt.pm * tstep : cA; const char* nB = has_next ? (const char*)g.Bt + (size_t)nxt.pn * tstep : cB;
        for (int t = 0; t < nt; t += 2) {
            const bool last = (t == nt - 2);
            const char* a1 = cA + (size_t)(t + 1) * kstep;
            const char* a2 = last ? nA : cA + (size_t)(t + 2) * kstep; const char* b2 = last ? nB : cB + (size_t)(t + 2) * kstep;
            const char* a3 = a2 + kstep; const char* b3 = b2 + kstep;
            if (last && has_next) S.a_ready(nxt);
            PG8_LDB(B0, 0, 0); PG8_SCHED; PG8_LDA(At, 0, 0); PG8_STAGE(PG8_SA(1, 1), a1 + hstep, voffA);
            PG8_WAIT_L(8); PG8_BAR; PG8_WAIT_L(0); PG8_MMA(0, 0, At, B0); PG8_BAR; PG8_SCHED;
            PG8_LDB(B1, 0, 1); PG8_STAGE(PG8_SB(0, 0), b2, voffB);
            PG8_BAR; PG8_WAIT_L(0); PG8_MMA(0, 1, At, B1); PG8_BAR;
            PG8_LDA(At, 0, 1); PG8_STAGE(PG8_SA(0, 0), a2, voffA);
            PG8_BAR; PG8_WAIT_L(0); PG8_MMA(1, 0, At, B0); PG8_BAR; PG8_SCHED;
            PG8_STAGE(PG8_SB(0, 1), b2 + hstep, voffB);
            PG8_WAIT_V(6); PG8_BAR; PG8_MMA(1, 1, At, B1); PG8_BAR;
            PG8_LDB(B0, 1, 0); PG8_SCHED; PG8_LDA(At, 1, 0); PG8_STAGE(PG8_SA(0, 1), a2 + hstep, voffA);
            PG8_WAIT_L(8); PG8_BAR; PG8_WAIT_L(0); PG8_MMA(0, 0, At, B0); PG8_BAR; PG8_SCHED;
            PG8_LDB(B1, 1, 1); PG8_STAGE(PG8_SB(1, 0), b3, voffB);
            PG8_BAR; PG8_WAIT_L(0); PG8_MMA(0, 1, At, B1); PG8_BAR;
            PG8_LDA(At, 1, 1); PG8_STAGE(PG8_SA(1, 0), a3, voffA);
            PG8_BAR; PG8_WAIT_L(0); PG8_MMA(1, 0, At, B0); PG8_BAR; PG8_SCHED;
            PG8_STAGE(PG8_SB(1, 1), b3 + hstep, voffB);
            PG8_WAIT_V(6); PG8_BAR; PG8_MMA(1, 1, At, B1); PG8_BAR;
        }
        if constexpr (!Epi::AFTER_DRAIN) { E(acc, cur, wr, wc, fr, fq); S.done(cur); }
        if (!has_next) break;
#pragma unroll
        for (int a = 0; a < 2; ++a)
#pragma unroll
            for (int b = 0; b < 2; ++b)
#pragma unroll
                for (int m = 0; m < 4; ++m)
#pragma unroll
                    for (int n = 0; n < 2; ++n) acc[a][b][m][n] = (f32x4){0.f, 0.f, 0.f, 0.f};
        cur = nxt; cA = nA; cB = nB; ++ui;
    }
    PG8_WAIT_V(0);
    if (wr == 0) PG8_BAR;
    PG8_BAR;
    if constexpr (Epi::AFTER_DRAIN) { E.fused(acc, cur, wr, wc, fr, fq, lds, wid, lane); S.done(cur); }
#undef PG8_SA
#undef PG8_SB
#undef PG8_STAGE

#undef PG8_LDA
#undef PG8_LDB
#undef PG8_MMA
#undef PG8_WAIT_V
#undef PG8_WAIT_L
#undef PG8_BAR
#undef PG8_SCHED
}

}

using pg8::ltid; using pg8::bf16_t; using pg8::bf16x8; using pg8::f32x4; using pg8::u32x4;
typedef unsigned u32x2 __attribute__((ext_vector_type(2)));
typedef PG8_LAS unsigned char* lptr;
typedef PG8_LAS float* lfptr;
namespace cg = cooperative_groups;

constexpr int NPR = 16384, NSM = 128, NRP = 16640;
constexpr int NPROJ = 4480, NPAD = 4608;
constexpr int C_MQ = 0, C_MK = 384, C_MV = 768, C_MO = 1152, C_MZ = 1536, C_RQ = 1920, C_RK = 2304, C_RV = 2688, C_RG = 3072, C_HF = 3456, C_HI = 3712, C_HQ = 3968, C_HG = 4224;
constexpr float ALPHA = 1.41421356237f;
constexpr float DH_SCALE = 0.10206207261596575f;
constexpr size_t WS_XM = 0, WS_WIN = 34078720, WS_WOUT = 52953088, WS_PROJ = 57147392, WS_GATES = 206241792, WS_UM = 206774272, WS_UR = 225648640,
                 WS_UH = 244523008, WS_NU = 252911616, WS_EG = 253304832, WS_SC = 253566976, WS_ROPE = 253583360, WS_END = 254370176;
constexpr size_t O_Y = 0, O_YS = 16777216, O_MC_P = 16908288, O_MN_P = 17498112, O_MM_P = 17504256, O_CONV_P = 17504320, O_RET_P = 17541184, O_HG_P = 18131008,
                 O_MC_S = 18393152, O_MN_S = 27830336, O_MM_S = 27928640, O_CONV_S = 27929664, O_RET_S = 28519488, O_HG_S = 37956672, O_END = 42150976;

struct Args {
    const float *x_prompt, *x_sample, *st_C, *st_n, *st_m, *st_conv, *st_ret, *st_hgrn, *w_in, *conv_w, *conv_b, *b_mgate, *m_norm_w, *r_norm_w, *h_norm_w, *hgrn_lb, *w_out, *ln_g, *ln_b;
    float* out; unsigned char* ws;
};

typedef __bf16 bf16x2_t __attribute__((ext_vector_type(2)));
typedef float f32x2_t __attribute__((ext_vector_type(2)));
__device__ __forceinline__ unsigned cvt_pk(float lo, float hi) { const f32x2_t v = {lo, hi}; const bf16x2_t b = __builtin_convertvector(v, bf16x2_t); return __builtin_bit_cast(unsigned, b); }
__device__ __forceinline__ bf16_t f2bf(float f) { return (bf16_t)(cvt_pk(f, 0.f) & 0xffffu); }
__device__ __forceinline__ float bf2f(bf16_t b) { return __uint_as_float(((unsigned)b) << 16); }
__device__ __forceinline__ float bflo(unsigned u) { return __uint_as_float(u << 16); }
__device__ __forceinline__ float bfhi(unsigned u) { return __uint_as_float(u & 0xffff0000u); }
__device__ __forceinline__ float sigmoidf_(float x) { return 1.0f / (1.0f + __expf(-x)); }
__device__ __forceinline__ float siluf_(float x) { return x / (1.0f + __expf(-x)); }
__device__ __forceinline__ float logsigmoidf_(float x) { return fminf(x, 0.f) - log1pf(__expf(-fabsf(x))); }
__device__ __forceinline__ float wave_scan_sum(float v, int lane) {
#pragma unroll
    for (int o = 1; o < 64; o <<= 1) { const float t = __shfl_up(v, o); if (lane >= o) v += t; } return v; }
__device__ __forceinline__ float wave_scan_max(float v, int lane) {
#pragma unroll
    for (int o = 1; o < 64; o <<= 1) { const float t = __shfl_up(v, o); if (lane >= o) v = fmaxf(v, t); } return v; }
__device__ __forceinline__ float wave_max(float v) {
#pragma unroll
    for (int o = 32; o; o >>= 1) v = fmaxf(v, __shfl_xor(v, o)); return v; }
__device__ __forceinline__ float wave_sum(float v) {
#pragma unroll
    for (int o = 32; o; o >>= 1) v += __shfl_xor(v, o); return v; }
template <int NK32> __device__ __forceinline__ f32x4 mma_k(lptr X, int ldx, lptr Y, int ldy, int fr, int fq, f32x4 acc) {
    lptr xp = X + fr * ldx + fq * 16; lptr yp = Y + fr * ldy + fq * 16;
#pragma unroll
    for (int k = 0; k < NK32; ++k) { const bf16x8 x = *(const PG8_LAS bf16x8*)(xp + k * 64); const bf16x8 y = *(const PG8_LAS bf16x8*)(yp + k * 64); acc = __builtin_amdgcn_mfma_f32_16x16x32_bf16(x, y, acc, 0, 0, 0); }
    return acc; }
__device__ __forceinline__ void st_tr8(lptr T, int pitch, int r0, int cbyte, u32x4 v) {
    *(PG8_LAS bf16_t*)(T + (r0 + 0) * pitch + cbyte) = (bf16_t)(v.x & 0xffff); *(PG8_LAS bf16_t*)(T + (r0 + 1) * pitch + cbyte) = (bf16_t)(v.x >> 16);
    *(PG8_LAS bf16_t*)(T + (r0 + 2) * pitch + cbyte) = (bf16_t)(v.y & 0xffff); *(PG8_LAS bf16_t*)(T + (r0 + 3) * pitch + cbyte) = (bf16_t)(v.y >> 16);
    *(PG8_LAS bf16_t*)(T + (r0 + 4) * pitch + cbyte) = (bf16_t)(v.z & 0xffff); *(PG8_LAS bf16_t*)(T + (r0 + 5) * pitch + cbyte) = (bf16_t)(v.z >> 16);
    *(PG8_LAS bf16_t*)(T + (r0 + 6) * pitch + cbyte) = (bf16_t)(v.w & 0xffff); *(PG8_LAS bf16_t*)(T + (r0 + 7) * pitch + cbyte) = (bf16_t)(v.w >> 16); }

__device__ __forceinline__ void phase_prologue(const Args& a, lptr lds) {
    const int tid = ltid();
    lfptr tile = (lfptr)lds;
    bf16_t* Win = (bf16_t*)(a.ws + WS_WIN); bf16_t* Wout = (bf16_t*)(a.ws + WS_WOUT);
    for (int it = blockIdx.x; it < 2304 + 512; it += gridDim.x) {
        const float* src; bf16_t* dst; int ld, so, nvalid, k0;
        if (it < 2304) { const int l = it / 1152, r = it % 1152, kt = r / 72, nt = r % 72, n0 = nt * 64; k0 = kt * 64;
            src = a.w_in + (size_t)l * 1024 * 4488; ld = 4488;
            if (n0 < 1920) { so = n0; nvalid = 64; } else if (n0 < 4480) { so = n0 + 8; nvalid = 64; } else if (n0 == 4480) { so = 1920; nvalid = 8; } else { so = 0; nvalid = 0; }
            dst = Win + ((size_t)l * NPAD + n0) * 1024 + k0;
        } else { const int r0 = it - 2304, l = r0 / 256, r = r0 % 256, kt = r / 16, nt = r % 16, n0 = nt * 64; k0 = kt * 64;
            src = a.w_out + (size_t)l * 1024 * 1024; ld = 1024; so = n0; nvalid = 64; dst = Wout + ((size_t)l * 1024 + n0) * 1024 + k0; }
#pragma unroll
        for (int i = 0; i < 8; ++i) { const int kk = (tid >> 6) + 8 * i, nn = tid & 63; tile[kk * 65 + nn] = nn < nvalid ? src[(size_t)(k0 + kk) * ld + so + nn] : 0.f; }
        __syncthreads();
        { const int nn = tid >> 3, kk0 = (tid & 7) * 8; float v[8];
#pragma unroll
          for (int j = 0; j < 8; ++j) v[j] = tile[(kk0 + j) * 65 + nn];
          u32x4 w; w.x = cvt_pk(v[0], v[1]); w.y = cvt_pk(v[2], v[3]); w.z = cvt_pk(v[4], v[5]); w.w = cvt_pk(v[6], v[7]);
          *(u32x4*)(dst + (size_t)nn * 1024 + kk0) = w; }
        __syncthreads();
    }
    bf16_t* XM = (bf16_t*)(a.ws + WS_XM);
    const int gt = blockIdx.x * 512 + tid, gs = gridDim.x * 512;
    for (int i = gt; i < (NPR + NSM) * 128; i += gs) { const int row = i >> 7, c8 = (i & 127) * 8;
        const float* s = row < NPR ? a.x_prompt + (size_t)row * 1024 + c8 : a.x_sample + (size_t)(row - NPR) * 1024 + c8;
        const f32x4 v0 = *(const f32x4*)s, v1 = *(const f32x4*)(s + 4);
        u32x4 w; w.x = cvt_pk(v0[0], v0[1]); w.y = cvt_pk(v0[2], v0[3]); w.z = cvt_pk(v1[0], v1[1]); w.w = cvt_pk(v1[2], v1[3]);
        *(u32x4*)(XM + (size_t)row * 1024 + c8) = w; }
    float* rope = (float*)(a.ws + WS_ROPE);
    for (int i = gt; i < 2049 * 48; i += gs) { const int p = i / 48, j = i % 48; const float pos = p < 2048 ? (float)p : 16384.0f;
        const float inv = powf(10000.0f, -(float)j / 48.0f); const float ang = pos * inv;
        const double x = (double)ang; const double n = rint(x * 0.15915494309189535); const float r = (float)(x - n * 6.283185307179586);
        rope[2 * i] = cosf(r); rope[2 * i + 1] = sinf(r); }
}

struct EpiProj {
    static constexpr bool PERM = true, AFTER_DRAIN = false;
    bf16_t* proj; float* gates;
    __device__ __forceinline__ void operator()(const f32x4 (&acc)[2][2][4][2], const pg8::Unit& u, int wr, int wc, int fr, int fq) const {
        const int row0 = u.pm * 256 + wr * 64 + fr, colb = u.pn * 256 + wc * 32 + 8 * fq;
#pragma unroll
        for (int ai = 0; ai < 2; ++ai)
#pragma unroll
            for (int m = 0; m < 4; ++m) { const int row = row0 + ai * 128 + m * 16;
#pragma unroll
                for (int bj = 0; bj < 2; ++bj) { const int c0 = colb + bj * 128; const f32x4 v0 = acc[ai][bj][m][0], v1 = acc[ai][bj][m][1];
                    if (c0 < NPROJ) { u32x4 w; w.x = cvt_pk(v0[0], v0[1]); w.y = cvt_pk(v0[2], v0[3]); w.z = cvt_pk(v1[0], v1[1]); w.w = cvt_pk(v1[2], v1[3]);
                        *(u32x4*)(proj + (size_t)row * NPROJ + c0) = w; }
                    else if (c0 == NPROJ) { *(f32x4*)(gates + (size_t)row * 8) = v0; *(f32x4*)(gates + (size_t)row * 8 + 4) = v1; } } }
    }
};
struct EpiOut {
    static constexpr bool PERM = false, AFTER_DRAIN = false;
    const float* xres; float* pre;
    __device__ __forceinline__ void operator()(const f32x4 (&acc)[2][2][4][2], const pg8::Unit& u, int wr, int wc, int fr, int fq) const {
        const int row0 = u.pm * 256 + wr * 64 + fr, col0 = u.pn * 256 + wc * 32 + 4 * fq;
#pragma unroll
        for (int ai = 0; ai < 2; ++ai)
#pragma unroll
            for (int m = 0; m < 4; ++m) { const size_t off = (size_t)(row0 + ai * 128 + m * 16) * 1024 + col0;
#pragma unroll
                for (int bj = 0; bj < 2; ++bj)
#pragma unroll
                    for (int n = 0; n < 2; ++n) { const f32x4 xr = *(const f32x4*)(xres + off + bj * 128 + n * 16); *(f32x4*)(pre + off + bj * 128 + n * 16) = xr * ALPHA + acc[ai][bj][m][n]; } }
    }
};

__device__ __forceinline__ void phase_ln(const Args& a, int layer) {
    const int tid = ltid(), wid = tid >> 6, lane = tid & 63;
    const float* pre = (const float*)(a.ws + WS_PROJ); const float* g = a.ln_g + layer * 1024; const float* bb = a.ln_b + layer * 1024;
    bf16_t* XM = (bf16_t*)(a.ws + WS_XM);
    for (int row = blockIdx.x * 8 + wid; row < NPR; row += gridDim.x * 8) {
        f32x4 v[4]; float s = 0.f;
#pragma unroll
        for (int i = 0; i < 4; ++i) { v[i] = *(const f32x4*)(pre + (size_t)row * 1024 + i * 256 + lane * 4); s += (v[i][0] + v[i][1]) + (v[i][2] + v[i][3]); }
        const float mu = wave_sum(s) * (1.0f / 1024.0f); float q = 0.f;
#pragma unroll
        for (int i = 0; i < 4; ++i) { const f32x4 d = v[i] - mu; q += (d[0] * d[0] + d[1] * d[1]) + (d[2] * d[2] + d[3] * d[3]); }
        const float rstd = rsqrtf(wave_sum(q) * (1.0f / 1024.0f) + 1e-5f);
#pragma unroll
        for (int i = 0; i < 4; ++i) { const int c = i * 256 + lane * 4; const f32x4 gg = *(const f32x4*)(g + c), b4 = *(const f32x4*)(bb + c); const f32x4 y = (v[i] - mu) * rstd * gg + b4;
            *(f32x4*)(a.out + O_Y + (size_t)row * 1024 + c) = y;
            if (layer == 0) { u32x2 w; w.x = cvt_pk(y[0], y[1]); w.y = cvt_pk(y[2], y[3]); *(u32x2*)(XM + (size_t)row * 1024 + c) = w; } }
    }
}

__device__ __forceinline__ float ret_lg(int h) { return log1pf(-exp2f(-5.0f - (float)h)); }

template <int MIX> __device__ __forceinline__ void m1_qkv(const Args& a, int layer, int it, lptr lds) {
    const int tid = ltid(), wid = tid >> 6, lane = tid & 63, fr = lane & 15, fq = lane >> 4;
    const int bh = it >> 5, c = it & 31, b = bh >> 2, h = bh & 3, row0 = b * 2048 + c * 64;
    const bf16_t* proj = (const bf16_t*)(a.ws + WS_PROJ);
    lptr KT = lds, VT = lds + 13824, RAW = lds + 27648; lfptr WV = (lfptr)(lds + 40512);
    const int kcol = (MIX == 0 ? C_MK : C_RK) + 96 * h, vcol = (MIX == 0 ? C_MV : C_RV) + 96 * h;
    constexpr int R0 = (MIX == 0) ? 3 : 0;
    for (int i = tid; i < (64 + R0) * 12; i += 512) { const int rr = i / 12, c8 = (i % 12) * 8, t = c * 64 - R0 + rr; u32x4 v = (u32x4){0u, 0u, 0u, 0u};
        if (t >= 0) v = *(const u32x4*)(proj + (size_t)(b * 2048 + t) * NPROJ + kcol + c8);
        *(PG8_LAS u32x4*)(RAW + rr * 192 + c8 * 2) = v; }
    for (int i = tid; i < 64 * 12; i += 512) { const int s = i / 12, c8 = (i % 12) * 8; const u32x4 v = *(const u32x4*)(proj + (size_t)(row0 + s) * NPROJ + vcol + c8); st_tr8(VT, 144, c8, s * 2, v); }
    float* sc = (float*)(a.ws + WS_SC);
    if (MIX == 0 && wid == 0) { const float* gt = (const float*)(a.ws + WS_GATES) + (size_t)(row0 + lane) * 8; const float* bm = a.b_mgate + layer * 8;
        const float ig = gt[h] + bm[h], lf = logsigmoidf_(gt[4 + h] + bm[4 + h]); const float bc = wave_scan_sum(lf, lane); const float G = __shfl(bc, 63);
        const float as = G - bc + ig; const float ml = wave_max(as); WV[lane] = __expf(as - ml);
        if (lane == 0) { sc[it * 4 + 0] = G; sc[it * 4 + 1] = ml; } }
    __syncthreads();
    if (MIX == 0) {
        if (tid < 480) { const int d = tid % 96, sg = tid / 96; const float* cw = a.conv_w + (size_t)layer * 4 * 768 + 384 + 96 * h + d;
            const float w0 = cw[0], w1 = cw[768], w2 = cw[1536], w3 = cw[2304], cb = a.conv_b[layer * 768 + 384 + 96 * h + d];
            for (int s = sg; s < 64; s += 5) {
                const float x0 = bf2f(*(PG8_LAS bf16_t*)(RAW + (s + 0) * 192 + d * 2)), x1 = bf2f(*(PG8_LAS bf16_t*)(RAW + (s + 1) * 192 + d * 2)),
                            x2 = bf2f(*(PG8_LAS bf16_t*)(RAW + (s + 2) * 192 + d * 2)), x3 = bf2f(*(PG8_LAS bf16_t*)(RAW + (s + 3) * 192 + d * 2));
                const float val = cb + w0 * x0 + w1 * x1 + w2 * x2 + w3 * x3;
                *(PG8_LAS bf16_t*)(KT + d * 144 + s * 2) = f2bf(siluf_(val) * WV[s] * DH_SCALE); } }
    } else {
        const float lg = ret_lg(h); const float* rope = (const float*)(a.ws + WS_ROPE);
        for (int i = tid; i < 64 * 48; i += 512) { const int s = i / 48, j = i % 48;
            const float x1 = bf2f(*(PG8_LAS bf16_t*)(RAW + s * 192 + j * 2)), x2 = bf2f(*(PG8_LAS bf16_t*)(RAW + s * 192 + (j + 48) * 2));
            const float cs = rope[((c * 64 + s) * 48 + j) * 2], sn = rope[((c * 64 + s) * 48 + j) * 2 + 1]; const float dec = __expf((float)(63 - s) * lg) * DH_SCALE;
            *(PG8_LAS bf16_t*)(KT + j * 144 + s * 2) = f2bf((x1 * cs - x2 * sn) * dec); *(PG8_LAS bf16_t*)(KT + (j + 48) * 144 + s * 2) = f2bf((x1 * sn + x2 * cs) * dec); }
    }
    __syncthreads();
    bf16_t* U = (bf16_t*)(a.ws + (MIX == 0 ? WS_UM : WS_UR)) + (size_t)it * 9216;
    for (int blk = wid; blk < 36; blk += 8) { const int vi = blk / 6, di = blk % 6;
        f32x4 acc = (f32x4){0.f, 0.f, 0.f, 0.f}; acc = mma_k<2>(KT + di * 16 * 144, 144, VT + vi * 16 * 144, 144, fr, fq, acc);
        u32x2 w; w.x = cvt_pk(acc[0], acc[1]); w.y = cvt_pk(acc[2], acc[3]); *(u32x2*)(U + (16 * vi + fr) * 96 + 16 * di + 4 * fq) = w; }
    if (MIX == 0 && tid < 96) { float s = 0.f;
#pragma unroll
        for (int k = 0; k < 8; ++k) { const u32x4 v = *(const PG8_LAS u32x4*)(KT + tid * 144 + k * 16); s += (bflo(v.x) + bfhi(v.x)) + (bflo(v.y) + bfhi(v.y)) + (bflo(v.z) + bfhi(v.z)) + (bflo(v.w) + bfhi(v.w)); }
        ((float*)(a.ws + WS_NU))[it * 96 + tid] = s; }
    __syncthreads();
}

__device__ __forceinline__ float hgrn_lb(const Args& a, int layer, int col) { return layer ? sigmoidf_(a.hgrn_lb[256 + col] - a.hgrn_lb[col]) : 0.f; }

__device__ __forceinline__ void m1_hgrn(const Args& a, int layer, int it, lptr lds) {
    const int tid = ltid(), wid = tid >> 6, lane = tid & 63, fr = lane & 15, fq = lane >> 4;
    const int bh = it >> 5, c = it & 31, b = bh >> 2, h = bh & 3, row0 = b * 2048 + c * 64;
    const bf16_t* proj = (const bf16_t*)(a.ws + WS_PROJ);
    lptr KT = lds, VT = lds + 9216; lfptr SEG = (lfptr)(lds + 18432);
    const int ch = tid & 63, seg = tid >> 6; const float lb = hgrn_lb(a, layer, 64 * h + ch);
    float kv[8], bc[8]; float run = 0.f;
#pragma unroll
    for (int i = 0; i < 8; ++i) { const float fp = bf2f(proj[(size_t)(row0 + seg * 8 + i) * NPROJ + C_HF + 64 * h + ch]); const float k = (1.0f - lb) / (1.0f + __expf(fp)); kv[i] = k; run += log1pf(-k); bc[i] = run; }
    SEG[seg * 64 + ch] = run;
    { const int s = tid >> 3, c8 = (tid & 7) * 8; const u32x4 v = *(const u32x4*)(proj + (size_t)(row0 + s) * NPROJ + C_HI + 64 * h + c8); st_tr8(VT, 144, c8, s * 2, v); }
    __syncthreads();
    float off = 0.f, tot = 0.f;
#pragma unroll
    for (int s2 = 0; s2 < 8; ++s2) { const float x = SEG[s2 * 64 + ch]; tot += x; if (s2 < seg) off += x; }
    { float o[8];
#pragma unroll
      for (int i = 0; i < 8; ++i) o[i] = kv[i] * __expf(tot - (off + bc[i]));
      u32x4 w; w.x = cvt_pk(o[0], o[1]); w.y = cvt_pk(o[2], o[3]); w.z = cvt_pk(o[4], o[5]); w.w = cvt_pk(o[6], o[7]); *(PG8_LAS u32x4*)(KT + ch * 144 + seg * 16) = w; }
    if (seg == 0) ((float*)(a.ws + WS_EG))[it * 64 + ch] = __expf(tot);
    __syncthreads();
    bf16_t* U = (bf16_t*)(a.ws + WS_UH) + (size_t)it * 4096;
    for (int blk = wid; blk < 16; blk += 8) { const int vi = blk >> 2, ci = blk & 3;
        f32x4 acc = (f32x4){0.f, 0.f, 0.f, 0.f}; acc = mma_k<2>(KT + ci * 16 * 144, 144, VT + vi * 16 * 144, 144, fr, fq, acc);
        u32x2 w; w.x = cvt_pk(acc[0], acc[1]); w.y = cvt_pk(acc[2], acc[3]); *(u32x2*)(U + (16 * vi + fr) * 64 + 16 * ci + 4 * fq) = w; }
    __syncthreads();
}

template <int K, int V> __device__ __forceinline__ void state_pass(const float* Min, float* Mout, lfptr qe, lfptr dk, lfptr kk, lfptr vv, lfptr numacc) {
    constexpr int V4 = V / 4, KG = 512 / V4; const int tid = ltid();
    if (tid < V4 * KG) { const int v4 = tid % V4, kg = tid / V4; f32x4 acc = (f32x4){0.f, 0.f, 0.f, 0.f}; const f32x4 vvv = *(const PG8_LAS f32x4*)(vv + 4 * v4);
        for (int k = kg; k < K; k += KG) { const f32x4 m = *(const f32x4*)(Min + k * V + 4 * v4); acc += m * qe[k]; *(f32x4*)(Mout + k * V + 4 * v4) = m * dk[k] + vvv * kk[k]; }
#pragma unroll
        for (int j = 0; j < 4; ++j) atomicAdd((float*)(numacc + 4 * v4 + j), acc[j]); }
}

__device__ __forceinline__ void sample_item(const Args& a, int layer, int idx, lptr lds) {
    const int tid = ltid(), lane = tid & 63;
    const int mix = idx / 512, b = (idx % 512) >> 2, h = idx & 3, row = NPR + b;
    const bf16_t* prow = (const bf16_t*)(a.ws + WS_PROJ) + (size_t)row * NPROJ; bf16_t* xm = (bf16_t*)(a.ws + WS_XM) + (size_t)row * 1024;
    lfptr qv = (lfptr)lds, kv = qv + 96, vv = kv + 96, dk = vv + 96, qe = dk + 96, numacc = qe + 96, hv = numacc + 96;
    if (mix == 0) {
        if (tid < 192) { const int col = tid < 96 ? 96 * h + tid : 384 + 96 * h + (tid - 96); const float cur = bf2f(prow[col]);
            const float* bufp = a.st_conv + ((size_t)(layer * 128 + b) * 3) * 768 + col; const float b0 = bufp[0], b1 = bufp[768], b2 = bufp[1536];
            const float* cw = a.conv_w + (size_t)layer * 4 * 768 + col; float val = a.conv_b[layer * 768 + col] + cw[0] * b0 + cw[768] * b1 + cw[1536] * b2 + cw[2304] * cur; val = siluf_(val);
            if (tid < 96) qv[tid] = val; else kv[tid - 96] = val * DH_SCALE;
            float* co = a.out + O_CONV_S + ((size_t)(layer * 128 + b) * 3) * 768 + col; co[0] = b1; co[768] = b2; co[1536] = cur; }
        else if (tid < 288) vv[tid - 192] = bf2f(prow[C_MV + 96 * h + tid - 192]);
        else if (tid < 384) numacc[tid - 288] = 0.f;
        __syncthreads();
        const float* gt = (const float*)(a.ws + WS_GATES) + (size_t)row * 8; const float* bm = a.b_mgate + layer * 8;
        const float ig = gt[h] + bm[h], lf = logsigmoidf_(gt[4 + h] + bm[4 + h]); const size_t sbh = (size_t)(layer * 128 + b) * 4 + h; const float mp = a.st_m[sbh];
        const float mt = fmaxf(ig, lf + mp), sfac = __expf(ig - mt), wpr = __expf(lf + mp - mt);
        const float* nin = a.st_n + sbh * 96;
        float pqk = qv[lane] * kv[lane], pqn = qv[lane] * nin[lane]; if (lane < 32) { pqk += qv[lane + 64] * kv[lane + 64]; pqn += qv[lane + 64] * nin[lane + 64]; }
        const float qk = wave_sum(pqk), qn = wave_sum(pqn);
        if (tid < 96) { dk[tid] = wpr; qe[tid] = qv[tid]; }
        __syncthreads();
        if (tid < 96) kv[tid] = kv[tid] * sfac;
        __syncthreads();
        state_pass<96, 96>(a.st_C + sbh * 9216, a.out + O_MC_S + sbh * 9216, qe, dk, kv, vv, numacc);
        __syncthreads();
        if (tid < 96) { const float s = qk * sfac; const float num = s * vv[tid] + wpr * numacc[tid]; const float den = s + wpr * qn; hv[tid] = num / fmaxf(fabsf(den), __expf(-mt));
            a.out[O_MN_S + sbh * 96 + tid] = wpr * nin[tid] + kv[tid]; if (tid == 0) a.out[O_MM_S + sbh] = mt; }
        __syncthreads();
        if (tid < 96) { float mu = 0.f; for (int i = 0; i < 96; ++i) mu += hv[i]; mu *= (1.0f / 96.0f); float q = 0.f; for (int i = 0; i < 96; ++i) { const float d = hv[i] - mu; q += d * d; }
            const float rstd = rsqrtf(q * (1.0f / 96.0f) + 1e-6f); const int col = 96 * h + tid;
            const float y = (hv[tid] - mu) * rstd * a.m_norm_w[layer * 384 + col] * sigmoidf_(bf2f(prow[C_MO + col])) * siluf_(bf2f(prow[C_MZ + col])); xm[col] = f2bf(y); }
    } else if (mix == 1) {
        const float lg = ret_lg(h), gam = __expf(lg); const float* rope = (const float*)(a.ws + WS_ROPE) + (size_t)2048 * 96;
        if (tid < 96) { const int which = tid / 48, j = tid % 48; const int base = (which == 0 ? C_RQ : C_RK) + 96 * h; const float x1 = bf2f(prow[base + j]), x2 = bf2f(prow[base + j + 48]);
            const float cs = rope[2 * j], sn = rope[2 * j + 1]; const float o1 = x1 * cs - x2 * sn, o2 = x1 * sn + x2 * cs;
            if (which == 0) { qv[j] = o1; qv[j + 48] = o2; } else { kv[j] = o1 * DH_SCALE; kv[j + 48] = o2 * DH_SCALE; } }
        else if (tid < 192) vv[tid - 96] = bf2f(prow[C_RV + 96 * h + tid - 96]);
        else if (tid < 288) { numacc[tid - 192] = 0.f; dk[tid - 192] = gam; }
        __syncthreads();
        float pqk = qv[lane] * kv[lane]; if (lane < 32) pqk += qv[lane + 64] * kv[lane + 64]; const float qk = wave_sum(pqk);
        const size_t sbh = (size_t)(layer * 128 + b) * 4 + h;
        state_pass<96, 96>(a.st_ret + sbh * 9216, a.out + O_RET_S + sbh * 9216, qv, dk, kv, vv, numacc);
        __syncthreads();
        if (tid < 96) hv[tid] = qk * vv[tid] + gam * numacc[tid];
        __syncthreads();
        if (tid < 96) { float mu = 0.f; for (int i = 0; i < 96; ++i) mu += hv[i]; mu *= (1.0f / 96.0f); float q = 0.f; for (int i = 0; i < 96; ++i) { const float d = hv[i] - mu; q += d * d; }
            const float rstd = rsqrtf(q * (1.0f / 96.0f) + 1e-6f); const int col = 96 * h + tid;
            const float y = (hv[tid] - mu) * rstd * a.r_norm_w[layer * 384 + col] * siluf_(bf2f(prow[C_RG + col])); xm[384 + col] = f2bf(y); }
    } else {
        if (tid < 64) { const int col = 64 * h + tid; const float lb = hgrn_lb(a, layer, col); const float fp = bf2f(prow[C_HF + col]); const float k = (1.0f - lb) / (1.0f + __expf(fp)); const float f = 1.0f - k;
            const float q = bf2f(prow[C_HQ + col]); qv[tid] = q; kv[tid] = k; dk[tid] = f; qe[tid] = q * f; vv[tid] = bf2f(prow[C_HI + col]); numacc[tid] = 0.f; }
        __syncthreads();
        const float qk = wave_sum(qv[lane] * kv[lane]);
        const size_t sbh = (size_t)(layer * 128 + b) * 4 + h;
        state_pass<64, 64>(a.st_hgrn + sbh * 4096, a.out + O_HG_S + sbh * 4096, qe, dk, kv, vv, numacc);
        __syncthreads();
        if (tid < 64) hv[tid] = qk * vv[tid] + numacc[tid];
        __syncthreads();
        if (tid < 64) { float q = 0.f; for (int i = 0; i < 64; ++i) q += hv[i] * hv[i]; const float rstd = rsqrtf(q * (1.0f / 64.0f) + 1e-6f); const int col = 64 * h + tid;
            const float y = hv[tid] * rstd * a.h_norm_w[layer * 256 + col] * siluf_(bf2f(prow[C_HG + col])); xm[768 + col] = f2bf(y); }
    }
    __syncthreads();
}

__device__ __forceinline__ void phase_m1(const Args& a, int layer, lptr lds) {
    for (int idx = blockIdx.x; idx < 3072 + 1536; idx += gridDim.x) {
        if (idx < 1024) m1_qkv<0>(a, layer, idx, lds);
        else if (idx < 2048) m1_qkv<1>(a, layer, idx - 1024, lds);
        else if (idx < 3072) m1_hgrn(a, layer, idx - 2048, lds);
        else sample_item(a, layer, idx - 3072, lds);
    }
}

__device__ __forceinline__ void ld8(const bf16_t* p, float (&u)[8]) { const u32x4 v = *(const u32x4*)p; u[0] = bflo(v.x); u[1] = bfhi(v.x); u[2] = bflo(v.y); u[3] = bfhi(v.y); u[4] = bflo(v.z); u[5] = bfhi(v.z); u[6] = bflo(v.w); u[7] = bfhi(v.w); }
__device__ __forceinline__ void st8(bf16_t* p, const float (&u)[8]) { u32x4 w; w.x = cvt_pk(u[0], u[1]); w.y = cvt_pk(u[2], u[3]); w.z = cvt_pk(u[4], u[5]); w.w = cvt_pk(u[6], u[7]); *(u32x4*)p = w; }

__device__ __forceinline__ void sample_out_ln(const Args& a, int layer, int item, lptr lds) {
    const int tid = ltid(), wid = tid >> 6, lane = tid & 63, fr = lane & 15, fq = lane >> 4;
    lptr AS = lds; lfptr PRE = (lfptr)(lds + 16 * 2064);
    bf16_t* XM = (bf16_t*)(a.ws + WS_XM) + (size_t)(NPR + 16 * item) * 1024;
    const bf16_t* W = (const bf16_t*)(a.ws + WS_WOUT) + (size_t)layer * 1024 * 1024;
    for (int i = tid; i < 16 * 128; i += 512) { const int r = i >> 7, c8 = (i & 127) * 8; *(PG8_LAS u32x4*)(AS + r * 2064 + c8 * 2) = *(const u32x4*)(XM + (size_t)r * 1024 + c8); }
    __syncthreads();
    const float* xres = (layer == 0 ? a.x_sample : a.out + O_YS) + (size_t)(16 * item) * 1024;
    for (int nb = wid; nb < 64; nb += 8) { f32x4 acc = (f32x4){0.f, 0.f, 0.f, 0.f};
        const bf16_t* wp = W + (size_t)(nb * 16 + fr) * 1024 + fq * 8; lptr ap = AS + fr * 2064 + fq * 16;
#pragma unroll 4
        for (int k = 0; k < 32; ++k) { const bf16x8 x = *(const bf16x8*)(wp + k * 32); const bf16x8 y = *(const PG8_LAS bf16x8*)(ap + k * 64); acc = __builtin_amdgcn_mfma_f32_16x16x32_bf16(x, y, acc, 0, 0, 0); }
        const int n0 = nb * 16 + 4 * fq; const f32x4 xr = *(const f32x4*)(xres + (size_t)fr * 1024 + n0);
        *(PG8_LAS f32x4*)(PRE + fr * 1028 + n0) = xr * ALPHA + acc; }
    __syncthreads();
    const float* g = a.ln_g + layer * 1024; const float* bb = a.ln_b + layer * 1024;
    for (int r = wid * 2; r < wid * 2 + 2; ++r) { f32x4 v[4]; float s = 0.f;
#pragma unroll
        for (int i = 0; i < 4; ++i) { v[i] = *(const PG8_LAS f32x4*)(PRE + r * 1028 + i * 256 + lane * 4); s += (v[i][0] + v[i][1]) + (v[i][2] + v[i][3]); }
        const float mu = wave_sum(s) * (1.0f / 1024.0f); float q = 0.f;
#pragma unroll
        for (int i = 0; i < 4; ++i) { const f32x4 d = v[i] - mu; q += (d[0] * d[0] + d[1] * d[1]) + (d[2] * d[2] + d[3] * d[3]); }
        const float rstd = rsqrtf(wave_sum(q) * (1.0f / 1024.0f) + 1e-5f);
#pragma unroll
        for (int i = 0; i < 4; ++i) { const int c = i * 256 + lane * 4; const f32x4 y = (v[i] - mu) * rstd * *(const f32x4*)(g + c) + *(const f32x4*)(bb + c);
            *(f32x4*)(a.out + O_YS + (size_t)(16 * item + r) * 1024 + c) = y;
            if (layer == 0) { u32x2 w; w.x = cvt_pk(y[0], y[1]); w.y = cvt_pk(y[2], y[3]); *(u32x2*)(XM + (size_t)r * 1024 + c) = w; } } }
    __syncthreads();
}

__device__ __forceinline__ void phase_m2(const Args& a, int layer, lptr lds) {
    const int tid = ltid(); float* sc = (float*)(a.ws + WS_SC);
    for (int task = blockIdx.x * 512 + tid; task < 93184; task += gridDim.x * 512) {
        if (task < 73728) {
            const bool isr = task >= 36864; const int t2 = isr ? task - 36864 : task; const int bh = t2 / 1152, e8 = t2 % 1152;
            bf16_t* base = (bf16_t*)(a.ws + (isr ? WS_UR : WS_UM)) + (size_t)bh * 32 * 9216 + e8 * 8;
            float C[8] = {0.f, 0.f, 0.f, 0.f, 0.f, 0.f, 0.f, 0.f}; float m = 0.f; const float g64 = __expf(64.0f * ret_lg(bh & 3));
            for (int c = 0; c < 32; ++c) { float u[8]; ld8(base + (size_t)c * 9216, u); float dC, sU;
                if (isr) { dC = g64; sU = 1.0f; } else { const float G = sc[(bh * 32 + c) * 4], ml = sc[(bh * 32 + c) * 4 + 1]; const float mn = fmaxf(G + m, ml); dC = __expf(G + m - mn); sU = __expf(ml - mn); m = mn; }
                st8(base + (size_t)c * 9216, C);
#pragma unroll
                for (int j = 0; j < 8; ++j) C[j] = dC * C[j] + sU * u[j]; }
            const int v = e8 / 12, d0 = (e8 % 12) * 8; float* o = a.out + (isr ? O_RET_P : O_MC_P) + ((size_t)layer * 32 + bh) * 9216;
#pragma unroll
            for (int j = 0; j < 8; ++j) o[(d0 + j) * 96 + v] = C[j];
        } else if (task < 90112) {
            const int t2 = task - 73728, bh = t2 / 512, e8 = t2 % 512; bf16_t* base = (bf16_t*)(a.ws + WS_UH) + (size_t)bh * 32 * 4096 + e8 * 8;
            const int v = e8 / 8, c0 = (e8 % 8) * 8; const float* eg = (const float*)(a.ws + WS_EG) + (size_t)bh * 32 * 64 + c0;
            float S[8] = {0.f, 0.f, 0.f, 0.f, 0.f, 0.f, 0.f, 0.f};
            for (int c = 0; c < 32; ++c) { float u[8]; ld8(base + (size_t)c * 4096, u); const f32x4 e0 = *(const f32x4*)(eg + c * 64), e1 = *(const f32x4*)(eg + c * 64 + 4);
                st8(base + (size_t)c * 4096, S);
#pragma unroll
                for (int j = 0; j < 4; ++j) { S[j] = e0[j] * S[j] + u[j]; S[j + 4] = e1[j] * S[j + 4] + u[j + 4]; } }
            float* o = a.out + O_HG_P + ((size_t)layer * 32 + bh) * 4096;
#pragma unroll
            for (int j = 0; j < 8; ++j) o[(c0 + j) * 64 + v] = S[j];
        } else {
            const int t3 = task - 90112, bh = t3 / 96, d = t3 % 96; float* nu = (float*)(a.ws + WS_NU) + (size_t)bh * 32 * 96 + d; float n = 0.f, m = 0.f;
            for (int c = 0; c < 32; ++c) { const float G = sc[(bh * 32 + c) * 4], ml = sc[(bh * 32 + c) * 4 + 1]; const float u = nu[c * 96]; const float mn = fmaxf(G + m, ml);
                nu[c * 96] = n; if (d == 0) sc[(bh * 32 + c) * 4 + 2] = m; n = __expf(G + m - mn) * n + __expf(ml - mn) * u; m = mn; }
            a.out[O_MN_P + ((size_t)layer * 32 + bh) * 96 + d] = n; if (d == 0) a.out[O_MM_P + layer * 32 + bh] = m;
        }
    }
    const int wb = (int)gridDim.x - 1 - (int)blockIdx.x;
    for (int item = wb; item < 8; item += gridDim.x) sample_out_ln(a, layer, item, lds);
}

template <int MIX> __device__ __forceinline__ void m3_qkv(const Args& a, int layer, int it, lptr lds) {
    const int tid = ltid(), wid = tid >> 6, lane = tid & 63, fr = lane & 15, fq = lane >> 4;
    const int bh = it >> 5, c = it & 31, b = bh >> 2, h = bh & 3, row0 = b * 2048 + c * 64;
    const bf16_t* proj = (const bf16_t*)(a.ws + WS_PROJ);
    lptr QS = lds, KS = lds + 13312, VT = lds + 26624, CT = lds + 40448, PS = lds + 60416, RAW = lds + 95232;
    lfptr HS = (lfptr)(lds + 69632); lfptr SC = (lfptr)(lds + 120960);
    lfptr rowterm = SC, gs = SC + 64, wprior = SC + 128, enm = SC + 192, rowsum = SC + 256, qn = SC + 320, nvec = SC + 384;
    constexpr int R0 = (MIX == 0) ? 3 : 0;
    const int qcol = (MIX == 0 ? C_MQ : C_RQ) + 96 * h, kcol = (MIX == 0 ? C_MK : C_RK) + 96 * h, vcol = (MIX == 0 ? C_MV : C_RV) + 96 * h;
    const float lg = ret_lg(h);
    for (int i = tid; i < (64 + R0) * 24; i += 512) { const int rr = i / 24, c8 = (i % 24) * 8, t = c * 64 - R0 + rr; u32x4 v = (u32x4){0u, 0u, 0u, 0u};
        if (t >= 0) v = *(const u32x4*)(proj + (size_t)(b * 2048 + t) * NPROJ + (c8 < 96 ? qcol + c8 : kcol + c8 - 96));
        *(PG8_LAS u32x4*)(RAW + rr * 384 + c8 * 2) = v; }
    for (int i = tid; i < 64 * 12; i += 512) { const int s = i / 12, c8 = (i % 12) * 8; const u32x4 v = *(const u32x4*)(proj + (size_t)(row0 + s) * NPROJ + vcol + c8); st_tr8(VT, 144, c8, s * 2, v); }
    { const bf16_t* U = (const bf16_t*)(a.ws + (MIX == 0 ? WS_UM : WS_UR)) + (size_t)it * 9216;
      for (int i = tid; i < 1152; i += 512) { const int v = i / 12, c8 = (i % 12) * 8; *(PG8_LAS u32x4*)(CT + v * 208 + c8 * 2) = *(const u32x4*)(U + v * 96 + c8); } }
    if (MIX == 0) {
        if (tid >= 64 && tid < 160) nvec[tid - 64] = ((const float*)(a.ws + WS_NU))[it * 96 + tid - 64];
        if (wid == 0) { const float* gt = (const float*)(a.ws + WS_GATES) + (size_t)(row0 + lane) * 8; const float* bm = a.b_mgate + layer * 8;
            const float ig = gt[h] + bm[h], lf = logsigmoidf_(gt[4 + h] + bm[4 + h]); const float bc = wave_scan_sum(lf, lane); const float g = ig - bc; const float pm = wave_scan_max(g, lane);
            const float mc = ((const float*)(a.ws + WS_SC))[it * 4 + 2]; const float M = fmaxf(pm, mc);
            rowterm[lane] = -M; gs[lane] = g; wprior[lane] = __expf(mc - M); enm[lane] = __expf(-(bc + M)); rowsum[lane] = 0.f; }
    }
    __syncthreads();
    if (MIX == 0) {
#pragma unroll
        for (int ci = 0; ci < 3; ++ci) { const int col = lane + 64 * ci; const int gcol = col < 96 ? 96 * h + col : 384 + 96 * h + col - 96;
            const float* cw = a.conv_w + (size_t)layer * 4 * 768 + gcol; const float w0 = cw[0], w1 = cw[768], w2 = cw[1536], w3 = cw[2304], cb = a.conv_b[layer * 768 + gcol];
            const float scl = col < 96 ? 1.0f : DH_SCALE; lptr dst = col < 96 ? QS + col * 2 : KS + (col - 96) * 2;
            float x0 = bf2f(*(PG8_LAS bf16_t*)(RAW + (8 * wid + 0) * 384 + col * 2)), x1 = bf2f(*(PG8_LAS bf16_t*)(RAW + (8 * wid + 1) * 384 + col * 2)), x2 = bf2f(*(PG8_LAS bf16_t*)(RAW + (8 * wid + 2) * 384 + col * 2));
#pragma unroll
            for (int i = 0; i < 8; ++i) { const int t = 8 * wid + i; const float x3 = bf2f(*(PG8_LAS bf16_t*)(RAW + (t + 3) * 384 + col * 2));
                const float val = cb + w0 * x0 + w1 * x1 + w2 * x2 + w3 * x3; *(PG8_LAS bf16_t*)(dst + t * 208) = f2bf(siluf_(val) * scl); x0 = x1; x1 = x2; x2 = x3; } }
        if (c == 31 && tid < 192) { const int gcol = tid < 96 ? 96 * h + tid : 384 + 96 * h + tid - 96; float* co = a.out + O_CONV_P + ((size_t)(layer * 8 + b) * 3) * 768 + gcol;
#pragma unroll
            for (int j = 0; j < 3; ++j) co[j * 768] = bf2f(*(PG8_LAS bf16_t*)(RAW + (64 + j) * 384 + tid * 2)); }
    } else {
        const float* rope = (const float*)(a.ws + WS_ROPE);
        for (int i = tid; i < 64 * 96; i += 512) { const int s = i / 96, jj = i % 96, which = jj / 48, j = jj % 48;
            const float x1 = bf2f(*(PG8_LAS bf16_t*)(RAW + s * 384 + (which * 96 + j) * 2)), x2 = bf2f(*(PG8_LAS bf16_t*)(RAW + s * 384 + (which * 96 + j + 48) * 2));
            const float cs = rope[((c * 64 + s) * 48 + j) * 2], sn = rope[((c * 64 + s) * 48 + j) * 2 + 1]; const float scl = which ? DH_SCALE : 1.0f; lptr dst = (which ? KS : QS) + s * 208;
            *(PG8_LAS bf16_t*)(dst + j * 2) = f2bf((x1 * cs - x2 * sn) * scl); *(PG8_LAS bf16_t*)(dst + (j + 48) * 2) = f2bf((x1 * sn + x2 * cs) * scl); }
    }
    __syncthreads();
    if (MIX == 0) { const int t = tid >> 3, part = tid & 7; float s = 0.f;
#pragma unroll
        for (int i = 0; i < 12; ++i) s += bf2f(*(PG8_LAS bf16_t*)(QS + t * 208 + (part * 12 + i) * 2)) * nvec[part * 12 + i];
        s += __shfl_xor(s, 1); s += __shfl_xor(s, 2); s += __shfl_xor(s, 4); if (part == 0) qn[t] = s; }
    { const int ti = wid >> 1;
#pragma unroll
      for (int sj = 0; sj < 2; ++sj) { const int si = 2 * (wid & 1) + sj; const int t = 16 * ti + fr, s0 = 16 * si + 4 * fq; u32x2 w = (u32x2){0u, 0u};
          if (si <= ti) { f32x4 acc = (f32x4){0.f, 0.f, 0.f, 0.f}; acc = mma_k<3>(KS + si * 16 * 208, 208, QS + ti * 16 * 208, 208, fr, fq, acc);
              float p[4];
#pragma unroll
              for (int j = 0; j < 4; ++j) { const int s = s0 + j; float dl; if (MIX == 0) dl = __expf(rowterm[t] + gs[s]); else dl = __expf((float)(t - s) * lg); p[j] = s <= t ? acc[j] * dl : 0.f; }
              if (MIX == 0) { float ps = (p[0] + p[1]) + (p[2] + p[3]); ps += __shfl_xor(ps, 16); ps += __shfl_xor(ps, 32); if (fq == 0) atomicAdd((float*)(rowsum + t), ps); }
              w.x = cvt_pk(p[0], p[1]); w.y = cvt_pk(p[2], p[3]); }
          *(PG8_LAS u32x2*)(PS + t * 144 + s0 * 2) = w; } }
    __syncthreads();
    { const int ti = wid >> 1; const int t = 16 * ti + fr;
#pragma unroll
      for (int vj = 0; vj < 3; ++vj) { const int vi = 3 * (wid & 1) + vj;
          f32x4 a1 = (f32x4){0.f, 0.f, 0.f, 0.f}, a2 = (f32x4){0.f, 0.f, 0.f, 0.f};
          a1 = mma_k<2>(VT + vi * 16 * 144, 144, PS + ti * 16 * 144, 144, fr, fq, a1);
          a2 = mma_k<3>(CT + vi * 16 * 208, 208, QS + ti * 16 * 208, 208, fr, fq, a2);
          f32x4 hq;
          if (MIX == 0) { const float wp = wprior[t]; const float den = rowsum[t] + qn[t] * wp; const float inv = 1.0f / fmaxf(fabsf(den), enm[t]); hq = (a1 + a2 * wp) * inv; }
          else { const float wp = __expf((float)(t + 1) * lg); hq = a1 + a2 * wp; }
          *(PG8_LAS f32x4*)(HS + t * 100 + 16 * vi + 4 * fq) = hq; } }
    __syncthreads();
    { const int t = tid >> 3, part = tid & 7; float hv[12]; float s = 0.f;
#pragma unroll
      for (int i = 0; i < 3; ++i) { const f32x4 x = *(const PG8_LAS f32x4*)(HS + t * 100 + part * 12 + 4 * i); hv[4 * i] = x[0]; hv[4 * i + 1] = x[1]; hv[4 * i + 2] = x[2]; hv[4 * i + 3] = x[3]; s += (x[0] + x[1]) + (x[2] + x[3]); }
      s += __shfl_xor(s, 1); s += __shfl_xor(s, 2); s += __shfl_xor(s, 4); const float mu = s * (1.0f / 96.0f); float q = 0.f;
#pragma unroll
      for (int i = 0; i < 12; ++i) { const float d = hv[i] - mu; q += d * d; }
      q += __shfl_xor(q, 1); q += __shfl_xor(q, 2); q += __shfl_xor(q, 4); const float rstd = rsqrtf(q * (1.0f / 96.0f) + 1e-6f);
      const int hc = 96 * h + part * 12; const bf16_t* pr = proj + (size_t)(row0 + t) * NPROJ; const float* nw = (MIX == 0 ? a.m_norm_w : a.r_norm_w) + layer * 384 + hc;
      bf16_t* mx = (bf16_t*)(a.ws + WS_XM) + (size_t)(row0 + t) * 1024 + (MIX == 0 ? 0 : 384) + hc;
#pragma unroll
      for (int i = 0; i < 3; ++i) { float y[4]; const u32x2 g1 = *(const u32x2*)(pr + (MIX == 0 ? C_MO : C_RG) + hc + 4 * i); float gg[4] = {bflo(g1.x), bfhi(g1.x), bflo(g1.y), bfhi(g1.y)};
          float zz[4] = {0.f, 0.f, 0.f, 0.f}; if (MIX == 0) { const u32x2 z1 = *(const u32x2*)(pr + C_MZ + hc + 4 * i); zz[0] = bflo(z1.x); zz[1] = bfhi(z1.x); zz[2] = bflo(z1.y); zz[3] = bfhi(z1.y); }
#pragma unroll
          for (int j = 0; j < 4; ++j) { const float gate = MIX == 0 ? sigmoidf_(gg[j]) * siluf_(zz[j]) : siluf_(gg[j]); y[j] = (hv[4 * i + j] - mu) * rstd * nw[4 * i + j] * gate; }
          u32x2 w; w.x = cvt_pk(y[0], y[1]); w.y = cvt_pk(y[2], y[3]); *(u32x2*)(mx + 4 * i) = w; } }
    __syncthreads();
}

__device__ __forceinline__ void m3_hgrn(const Args& a, int layer, int it, lptr lds) {
    const int tid = ltid(), wid = tid >> 6, lane = tid & 63, fr = lane & 15, fq = lane >> 4;
    const int bh = it >> 5, c = it & 31, b = bh >> 2, h = bh & 3, row0 = b * 2048 + c * 64;
    const bf16_t* proj = (const bf16_t*)(a.ws + WS_PROJ);
    lfptr BC = (lfptr)lds;
    lptr QH = lds + 16640, QT = lds + 25856, KI = lds + 35072  , VT = lds + 71936, ST = lds + 81152, PS = lds + 90368; lfptr HS = (lfptr)(lds + 99584); lfptr SEG = (lfptr)(lds + 116992);
    const int ch = tid & 63, seg = tid >> 6; const float lb = hgrn_lb(a, layer, 64 * h + ch);
    float kv[8], bc[8]; float run = 0.f;
#pragma unroll
    for (int i = 0; i < 8; ++i) { const float fp = bf2f(proj[(size_t)(row0 + seg * 8 + i) * NPROJ + C_HF + 64 * h + ch]); const float k = (1.0f - lb) / (1.0f + __expf(fp)); kv[i] = k; run += log1pf(-k); bc[i] = run; }
    SEG[seg * 64 + ch] = run;
    { const int s = tid >> 3, c8 = (tid & 7) * 8; const u32x4 v = *(const u32x4*)(proj + (size_t)(row0 + s) * NPROJ + C_HI + 64 * h + c8); st_tr8(VT, 144, c8, s * 2, v);
      *(PG8_LAS u32x4*)(ST + s * 144 + c8 * 2) = *(const u32x4*)((const bf16_t*)(a.ws + WS_UH) + (size_t)it * 4096 + s * 64 + c8);
      *(PG8_LAS u32x4*)(PS + s * 144 + c8 * 2) = (u32x4){0u, 0u, 0u, 0u}; }
    __syncthreads();
    float off = 0.f;
#pragma unroll
    for (int s2 = 0; s2 < 8; ++s2) { const float x = SEG[s2 * 64 + ch]; if (s2 < seg) off += x; }
#pragma unroll
    for (int i = 0; i < 8; ++i) { bc[i] += off; BC[(seg * 8 + i) * 65 + ch] = bc[i]; }
    __syncthreads();
    { const int ib = seg >> 1;
      const float refq = ib ? BC[(16 * ib - 1) * 65 + ch] : 0.f;
#pragma unroll
      for (int i = 0; i < 8; ++i) { const int t = seg * 8 + i; const float q = bf2f(proj[(size_t)(row0 + t) * NPROJ + C_HQ + 64 * h + ch]);
          *(PG8_LAS bf16_t*)(QH + t * 144 + ch * 2) = f2bf(q * __expf(bc[i])); *(PG8_LAS bf16_t*)(QT + t * 144 + ch * 2) = f2bf(q * __expf(bc[i] - refq)); }
      for (int ii = ib; ii < 4; ++ii) { const float ref = ii ? BC[(16 * ii - 1) * 65 + ch] : 0.f;
#pragma unroll
          for (int i = 0; i < 8; ++i) { const int s = seg * 8 + i; *(PG8_LAS bf16_t*)(KI + ii * 9216 + s * 144 + ch * 2) = f2bf(kv[i] * __expf(ref - bc[i])); } } }
    __syncthreads();
    for (int blk = wid; blk < 10; blk += 8) { int ti, si; if (blk == 0) { ti = 0; si = 0; } else if (blk < 3) { ti = 1; si = blk - 1; } else if (blk < 6) { ti = 2; si = blk - 3; } else { ti = 3; si = blk - 6; }
        f32x4 acc = (f32x4){0.f, 0.f, 0.f, 0.f}; acc = mma_k<2>(KI + ti * 9216 + si * 16 * 144, 144, QT + ti * 16 * 144, 144, fr, fq, acc);
        const int t = 16 * ti + fr, s0 = 16 * si + 4 * fq; float p[4];
#pragma unroll
        for (int j = 0; j < 4; ++j) p[j] = (s0 + j) <= t ? acc[j] : 0.f;
        u32x2 w; w.x = cvt_pk(p[0], p[1]); w.y = cvt_pk(p[2], p[3]); *(PG8_LAS u32x2*)(PS + t * 144 + s0 * 2) = w; }
    __syncthreads();
    { const int ti = wid >> 1; const int t = 16 * ti + fr;
#pragma unroll
      for (int vj = 0; vj < 2; ++vj) { const int vi = 2 * (wid & 1) + vj; f32x4 acc = (f32x4){0.f, 0.f, 0.f, 0.f};
          acc = mma_k<2>(VT + vi * 16 * 144, 144, PS + ti * 16 * 144, 144, fr, fq, acc); acc = mma_k<2>(ST + vi * 16 * 144, 144, QH + ti * 16 * 144, 144, fr, fq, acc);
          *(PG8_LAS f32x4*)(HS + t * 68 + 16 * vi + 4 * fq) = acc; } }
    __syncthreads();
    { const int t = tid >> 3, part = tid & 7; const f32x4 x0 = *(const PG8_LAS f32x4*)(HS + t * 68 + part * 8), x1 = *(const PG8_LAS f32x4*)(HS + t * 68 + part * 8 + 4);
      float q = (x0[0] * x0[0] + x0[1] * x0[1]) + (x0[2] * x0[2] + x0[3] * x0[3]) + (x1[0] * x1[0] + x1[1] * x1[1]) + (x1[2] * x1[2] + x1[3] * x1[3]);
      q += __shfl_xor(q, 1); q += __shfl_xor(q, 2); q += __shfl_xor(q, 4); const float rstd = rsqrtf(q * (1.0f / 64.0f) + 1e-6f);
      const int hc = 64 * h + part * 8; const u32x4 g = *(const u32x4*)(proj + (size_t)(row0 + t) * NPROJ + C_HG + hc); const float* nw = a.h_norm_w + layer * 256 + hc;
      const f32x4 n0 = *(const f32x4*)nw, n1 = *(const f32x4*)(nw + 4);
      u32x4 w; w.x = cvt_pk(x0[0] * rstd * n0[0] * siluf_(bflo(g.x)), x0[1] * rstd * n0[1] * siluf_(bfhi(g.x))); w.y = cvt_pk(x0[2] * rstd * n0[2] * siluf_(bflo(g.y)), x0[3] * rstd * n0[3] * siluf_(bfhi(g.y)));
      w.z = cvt_pk(x1[0] * rstd * n1[0] * siluf_(bflo(g.z)), x1[1] * rstd * n1[1] * siluf_(bfhi(g.z))); w.w = cvt_pk(x1[2] * rstd * n1[2] * siluf_(bflo(g.w)), x1[3] * rstd * n1[3] * siluf_(bfhi(g.w)));
      *(u32x4*)((bf16_t*)(a.ws + WS_XM) + (size_t)(row0 + t) * 1024 + 768 + hc) = w; }
    __syncthreads();
}

__device__ __forceinline__ void phase_m3(const Args& a, int layer, lptr lds) {
    for (int idx = blockIdx.x; idx < 3072; idx += gridDim.x) {
        if (idx < 1024) m3_qkv<0>(a, layer, idx, lds);
        else if (idx < 2048) m3_qkv<1>(a, layer, idx - 1024, lds);
        else m3_hgrn(a, layer, idx - 2048, lds);
    }
}


#ifdef DBG_NAN
__device__ __forceinline__ void scan_bf16(const void* p, size_t n, unsigned* cnt) { const unsigned short* q = (const unsigned short*)p; unsigned c = 0;
    for (size_t i = (size_t)blockIdx.x * 512 + ltid(); i < n; i += (size_t)gridDim.x * 512) c += ((q[i] & 0x7f80u) == 0x7f80u) ? 1u : 0u;
    if (c) atomicAdd(cnt, c); }
__device__ __forceinline__ void scan_f32(const void* p, size_t n, unsigned* cnt) { const unsigned* q = (const unsigned*)p; unsigned c = 0;
    for (size_t i = (size_t)blockIdx.x * 512 + ltid(); i < n; i += (size_t)gridDim.x * 512) c += ((q[i] & 0x7f800000u) == 0x7f800000u) ? 1u : 0u;
    if (c) atomicAdd(cnt, c); }
__device__ __forceinline__ void dbg_scan(const Args& a, int ph, int layer, int sub) {
    unsigned* cnt = (unsigned*)(a.ws + WS_END) + ph;
    if (sub == -1) { scan_bf16(a.ws + WS_XM, (size_t)16512 * 1024, cnt); scan_bf16(a.ws + WS_WIN, (size_t)2 * NPAD * 1024, cnt); scan_bf16(a.ws + WS_WOUT, (size_t)2 * 1024 * 1024, cnt); scan_f32(a.ws + WS_ROPE, 2049 * 96, cnt); }
    else if (sub == 0) { scan_bf16(a.ws + WS_PROJ, (size_t)16512 * NPROJ, cnt); scan_f32(a.ws + WS_GATES, 16512 * 8, cnt); }
    else if (sub == 1 && layer == 0) { unsigned* c2 = (unsigned*)(a.ws + WS_END) + 16; scan_bf16(a.ws + WS_UM, (size_t)1024 * 9216, c2 + 1); scan_bf16(a.ws + WS_UR, (size_t)1024 * 9216, c2 + 2); scan_bf16(a.ws + WS_UH, (size_t)1024 * 4096, c2 + 3);
        scan_f32(a.ws + WS_NU, 1024 * 96, c2 + 4); scan_f32(a.ws + WS_EG, 1024 * 64, c2 + 5); scan_bf16(a.ws + WS_XM + (size_t)NPR * 2048, 128 * 1024, c2 + 6);
        scan_f32(a.out + O_MC_S + (size_t)layer * 128 * 4 * 9216, (size_t)128 * 4 * 9216, c2 + 7); scan_f32(a.out + O_RET_S + (size_t)layer * 128 * 4 * 9216, (size_t)128 * 4 * 9216, c2 + 8); scan_f32(a.out + O_HG_S + (size_t)layer * 128 * 4 * 4096, (size_t)128 * 4 * 4096, c2 + 9);
        { const unsigned short* q = (const unsigned short*)(a.ws + WS_PROJ); unsigned c = 0; for (size_t i = (size_t)blockIdx.x * 512 + ltid(); i < (size_t)16512 * NPROJ; i += (size_t)gridDim.x * 512) c += ((q[i] & 0x7f80u) >= 0x4300u) ? 1u : 0u; if (c) atomicAdd(c2 + 10, c); } }
    else if (sub == 2) { scan_bf16(a.ws + WS_UM, (size_t)1024 * 9216, cnt); scan_bf16(a.ws + WS_UR, (size_t)1024 * 9216, cnt); scan_bf16(a.ws + WS_UH, (size_t)1024 * 4096, cnt);
        scan_f32(a.ws + WS_NU, 1024 * 96, cnt); scan_bf16(a.ws + WS_XM + (size_t)NPR * 2048, 128 * 1024, cnt); scan_f32(a.out + O_YS, 128 * 1024, cnt); scan_f32(a.out + O_MC_P, O_MC_S - O_MC_P, cnt); }
    else if (sub == 3) { scan_bf16(a.ws + WS_XM, (size_t)NPR * 1024, cnt); }
    else if (sub == 4) { scan_f32(a.ws + WS_PROJ, (size_t)NPR * 1024, cnt); }
    else { scan_f32(a.out + O_Y, (size_t)NPR * 1024, cnt); }
}
#endif

#ifdef DBG_G1
__device__ __forceinline__ void dbg_g1(const Args& a) {
    unsigned* mx = (unsigned*)(a.ws + WS_END) + 40; const bf16_t* proj = (const bf16_t*)(a.ws + WS_PROJ); const float* gates = (const float*)(a.ws + WS_GATES);
    for (unsigned idx = blockIdx.x * 512 + ltid(); idx < 16384u; idx += gridDim.x * 512) {
        const unsigned h1 = idx * 2654435761u, h2 = (idx ^ 0x5bd1e995u) * 2246822519u; const int r = (int)((h1 >> 8) % 16512u), c = (int)((h2 >> 8) % 4488u);
        const float* xr = r < NPR ? a.x_prompt + (size_t)r * 1024 : a.x_sample + (size_t)(r - NPR) * 1024; float dot = 0.f;
        for (int k = 0; k < 1024; ++k) dot += xr[k] * a.w_in[(size_t)k * 4488 + c];
        const int n = c < 1920 ? c : (c < 1928 ? 4480 + (c - 1920) : c - 8);
        const float val = n < 4480 ? bf2f(proj[(size_t)r * NPROJ + n]) : gates[(size_t)r * 8 + n - 4480];
        float d = fabsf(val - dot); if (!(d == d)) d = 1e30f; atomicMax(mx, __float_as_uint(d)); }
}
#endif
__device__ __forceinline__ void gsync(cg::grid_group& grid) {
    __builtin_amdgcn_fence(__ATOMIC_RELEASE, "agent");
    asm volatile("s_waitcnt vmcnt(0) lgkmcnt(0)" ::: "memory");
    grid.sync();
    __builtin_amdgcn_fence(__ATOMIC_ACQUIRE, "agent");
    asm volatile("s_waitcnt vmcnt(0)" ::: "memory");
}
__global__ void __launch_bounds__(512) hybrid_fwd(Args a) {
    extern __shared__ __attribute__((aligned(16))) unsigned char smem[];
    lptr lds = (lptr)smem;
    cg::grid_group grid = cg::this_grid();
#if defined(DBG_NAN) || defined(DBG_G1)
    if (blockIdx.x == 0 && ltid() < 64) ((unsigned*)(a.ws + WS_END))[ltid()] = 0u;
#endif
#pragma nounroll
    for (int ph = 0; ph < 13; ++ph) {
        const int layer = ph > 6 ? 1 : 0; const int sub = ph == 0 ? -1 : (ph - 1) % 6;
        if (sub == -1) phase_prologue(a, lds);
        else if (sub == 0) { pg8::Gemm g; g.A = (const bf16_t*)(a.ws + WS_XM); g.Bt = (const bf16_t*)(a.ws + WS_WIN) + (size_t)layer * NPAD * 1024; g.M = NRP; g.N = NPAD; g.K = 1024;
            pg8::StaticOrder S; S.init(g.M, g.N, (int)gridDim.x, (int)blockIdx.x);
            EpiProj E; E.proj = (bf16_t*)(a.ws + WS_PROJ); E.gates = (float*)(a.ws + WS_GATES);
            pg8::gemm_phase<EpiProj, pg8::StaticOrder>(lds, g, S, E); }
        else if (sub == 1) phase_m1(a, layer, lds);
        else if (sub == 2) phase_m2(a, layer, lds);
        else if (sub == 3) phase_m3(a, layer, lds);
        else if (sub == 4) { pg8::Gemm g; g.A = (const bf16_t*)(a.ws + WS_XM); g.Bt = (const bf16_t*)(a.ws + WS_WOUT) + (size_t)layer * 1024 * 1024; g.M = NPR; g.N = 1024; g.K = 1024;
            pg8::StaticOrder S; S.init(g.M, g.N, (int)gridDim.x, (int)blockIdx.x);
            EpiOut E; E.xres = layer == 0 ? a.x_prompt : a.out + O_Y; E.pre = (float*)(a.ws + WS_PROJ);
            pg8::gemm_phase<EpiOut, pg8::StaticOrder>(lds, g, S, E); }
        else phase_ln(a, layer);
#ifdef DBG_NAN
        gsync(grid); dbg_scan(a, ph, layer, sub); gsync(grid);
#elif defined(DBG_G1)
        gsync(grid); if (ph == 1) { dbg_g1(a); gsync(grid); break; }
#else
        if (ph < 12) gsync(grid);
#endif
    }
#ifdef DBG_G1
    for (size_t i = (size_t)blockIdx.x * 512 + ltid(); i < O_END; i += (size_t)gridDim.x * 512) a.out[i] = 0.f;
    gsync(grid);
    if (blockIdx.x == 0 && ltid() == 0) a.out[0] = 1.0e6f * __uint_as_float(((const unsigned*)(a.ws + WS_END))[40]);
#endif
#ifdef DBG_NAN
    for (size_t i = (size_t)blockIdx.x * 512 + ltid(); i < O_END; i += (size_t)gridDim.x * 512) a.out[i] = 0.f;
    gsync(grid);
    if (blockIdx.x == 0 && ltid() == 0) { const unsigned* cnt = (const unsigned*)(a.ws + WS_END); a.out[0] = 1.0e5f * (float)((cnt[17] ? 1 : 0) + (cnt[18] ? 2 : 0) + (cnt[19] ? 4 : 0)) + 1.0e4f * (float)((cnt[20] ? 1 : 0) + (cnt[21] ? 2 : 0) + (cnt[22] ? 4 : 0)); }
#endif
}

extern "C" void kernel_launch(void* const* d_in, const int* in_sizes, int n_in, void* d_out, int out_size, void* d_ws, size_t ws_size, hipStream_t stream) {
    static int grid = 0;
    constexpr int LDSB = 131072;
    if (!grid) {
        int dev = 0, cus = 0, per_cu = 0;
        (void)hipGetDevice(&dev);
        (void)hipDeviceGetAttribute(&cus, hipDeviceAttributeMultiprocessorCount, dev);
        (void)hipFuncSetAttribute((const void*)hybrid_fwd, hipFuncAttributeMaxDynamicSharedMemorySize, LDSB);
        (void)hipOccupancyMaxActiveBlocksPerMultiprocessor(&per_cu, (const void*)hybrid_fwd, 512, LDSB);
        if (per_cu < 1) per_cu = 1;
        grid = cus * per_cu;
        if (n_in != 19 || out_size != (int)O_END || ws_size < WS_END) fprintf(stderr, "kernel_launch: unexpected sizes n_in %d out %d ws %zu\n", n_in, out_size, ws_size);
        fprintf(stderr, "kernel_launch: grid %d (cus %d x %d)\n", grid, cus, per_cu);
    }
    Args a{};
    a.x_prompt = (const float*)d_in[0]; a.x_sample = (const float*)d_in[1]; a.st_C = (const float*)d_in[2]; a.st_n = (const float*)d_in[3]; a.st_m = (const float*)d_in[4];
    a.st_conv = (const float*)d_in[5]; a.st_ret = (const float*)d_in[6]; a.st_hgrn = (const float*)d_in[7]; a.w_in = (const float*)d_in[8]; a.conv_w = (const float*)d_in[9];
    a.conv_b = (const float*)d_in[10]; a.b_mgate = (const float*)d_in[11]; a.m_norm_w = (const float*)d_in[12]; a.r_norm_w = (const float*)d_in[13]; a.h_norm_w = (const float*)d_in[14];
    a.hgrn_lb = (const float*)d_in[15]; a.w_out = (const float*)d_in[16]; a.ln_g = (const float*)d_in[17]; a.ln_b = (const float*)d_in[18];
    a.out = (float*)d_out; a.ws = (unsigned char*)d_ws;
    void* args[] = {&a};
    hipError_t e = hipLaunchCooperativeKernel((const void*)hybrid_fwd, dim3(grid), dim3(512), args, LDSB, stream);
    if (e != hipSuccess) fprintf(stderr, "cooperative launch failed: %s (grid %d)\n", hipGetErrorString(e), grid);
}
```

```cpp
#include <hip/hip_runtime.h>
#include <hip/hip_cooperative_groups.h>
#include <cstdio>
namespace pg8 {
#define PG8_LAS __attribute__((address_space(3)))
typedef unsigned short bf16_t;
typedef short bf16x8 __attribute__((ext_vector_type(8)));
typedef float f32x4 __attribute__((ext_vector_type(4)));
typedef unsigned u32x4 __attribute__((ext_vector_type(4)));
constexpr int BM = 256, BK = 64, HALF = 128, HTB = HALF * BK * 2  , STAGE_BYTES = 8 * HTB, NXCD = 8, WGM = 8;


__device__ __forceinline__ int ltid() { int t = threadIdx.x; asm volatile("" : "+v"(t)); return t; }
__host__ __device__ __forceinline__ int lds_byte(int r, int c) { const int st = (r >> 4) * 2 + (c >> 5), rr = r & 15, cc = c & 31, ob = rr * 64 + cc * 2; return st * 1024 + (ob ^ (((ob >> 9) & 1) << 5)); }
__host__ __device__ __forceinline__ void stage_rc(int b, int& R, int& C) { const int st = b / 1024, sb = b % 1024, swz = sb ^ (((sb >> 9) & 1) << 5); R = (st >> 1) * 16 + swz / 64; C = (st & 1) * 32 + (swz % 64) / 2; }
__host__ __device__ __forceinline__ int perm32(int rho) { const int n = rho >> 4, i = rho & 15; return 8 * (i >> 2) + 4 * n + (i & 3); }

struct Unit { int pm, pn; };
struct Gemm { const bf16_t* A; const bf16_t* Bt; int M, N, K; };
struct StaticOrder {
    int nM, nN, nwg, G, c;
    __host__ __device__ void init(int M, int N, int G_, int c_) { nM = M / BM; nN = N / BM; nwg = nM * nN; G = G_; c = c_; }
    __host__ __device__ bool next(int i, Unit& u) const {
        const long L = (long)i * G + c; if (L >= nwg) return false;
        int wgid = (int)L; { const int q = nwg / NXCD, r = nwg % NXCD, xcd = wgid % NXCD, off = wgid / NXCD; wgid = (xcd < r ? xcd * (q + 1) : r * (q + 1) + (xcd - r) * q) + off; }
        const int nig = WGM * nN, gid = wgid / nig, fm = gid * WGM, gsz = (nM - fm) < WGM ? (nM - fm) : WGM;
        u.pm = fm + ((wgid % nig) % gsz); u.pn = (wgid % nig) / gsz; return true;
    }
    __device__ __forceinline__ void a_ready(const Unit&) const {}
    __device__ __forceinline__ void done(const Unit&) const {}
};

template <class Epi, class Sched>
__device__ __forceinline__ void gemm_phase(PG8_LAS unsigned char* lds, const Gemm g, const Sched& S, const Epi& E) {
    const int tid = ltid(), wid = __builtin_amdgcn_readfirstlane(tid >> 6), lane = tid & 63, wr = wid >> 2, wc = wid & 3, fr = lane & 15, fq = lane >> 4;
    const int K = g.K, nt = K / BK;
    unsigned voffA[2], voffB[2];
#pragma unroll
    for (int i = 0; i < 2; ++i) { int R, C; stage_rc(tid * 16 + i * 8192, R, C); const int Rb = Epi::PERM ? ((R & ~31) + perm32(R & 31)) : R;
        voffA[i] = (unsigned)(R * K + C) * 2u; voffB[i] = (unsigned)(Rb * K + C) * 2u; }
    const size_t kstep = (size_t)(BK * 2);
    const size_t hstep = (size_t)HALF * K * 2;
    const size_t tstep = 2 * hstep;
    const unsigned ldsw = (unsigned)wid * 1024u;
    const int aoff = lds_byte(wr * 64 + fr, fq * 8), boff = lds_byte(wc * 32 + fr, fq * 8);
#define PG8_SA(b, h) (((b) * 2 + (h)) * HTB)
#define PG8_SB(b, h) ((4 + (b) * 2 + (h)) * HTB)
#define PG8_STAGE(bufoff, gbase, voff) do { _Pragma("unroll") for (int _i = 0; _i < 2; ++_i) \
        __builtin_amdgcn_global_load_lds((const unsigned*)((const char*)(gbase) + (voff)[_i]), (PG8_LAS unsigned*)(lds + (bufoff) + ldsw + _i * 8192), 16, 0, 0); } while (0)
#define PG8_LDA(dst, b, h) do { _Pragma("unroll") for (int m = 0; m < 4; ++m) _Pragma("unroll") for (int k = 0; k < 2; ++k) dst[m][k] = *(const PG8_LAS bf16x8*)(lds + PG8_SA(b, h) + aoff + m * 2048 + k * 1024); } while (0)
#define PG8_LDB(dst, b, h) do { _Pragma("unroll") for (int n = 0; n < 2; ++n) _Pragma("unroll") for (int k = 0; k < 2; ++k) dst[n][k] = *(const PG8_LAS bf16x8*)(lds + PG8_SB(b, h) + boff + n * 2048 + k * 1024); } while (0)
#define PG8_MMA(ai, bj, At, Bt) do { __builtin_amdgcn_s_setprio(1); _Pragma("unroll") for (int m = 0; m < 4; ++m) _Pragma("unroll") for (int n = 0; n < 2; ++n) _Pragma("unroll") for (int k = 0; k < 2; ++k) \
        acc[ai][bj][m][n] = __builtin_amdgcn_mfma_f32_16x16x32_bf16(Bt[n][k], At[m][k], acc[ai][bj][m][n], 0, 0, 0); __builtin_amdgcn_s_setprio(0); } while (0)
#define PG8_WAIT_V(n) asm volatile("s_waitcnt vmcnt(" #n ")" ::: "memory")
#define PG8_WAIT_L(n) asm volatile("s_waitcnt lgkmcnt(" #n ")" ::: "memory")
#define PG8_BAR __builtin_amdgcn_s_barrier()
#define PG8_SCHED __builtin_amdgcn_sched_barrier(0)
    Unit cur, nxt; int ui = 0;
    if (!S.next(0, cur)) return;
    f32x4 acc[2][2][4][2];
#pragma unroll
    for (int a = 0; a < 2; ++a)
#pragma unroll
        for (int b = 0; b < 2; ++b)
#pragma unroll
            for (int m = 0; m < 4; ++m)
#pragma unroll
                for (int n = 0; n < 2; ++n) acc[a][b][m][n] = (f32x4){0.f, 0.f, 0.f, 0.f};
    bf16x8 At[4][2], B0[2][2], B1[2][2];
    const char* cA = (const char*)g.A + (size_t)cur.pm * tstep; const char* cB = (const char*)g.Bt + (size_t)cur.pn * tstep;
    S.a_ready(cur);
    PG8_STAGE(PG8_SB(0, 0), cB, voffB); PG8_STAGE(PG8_SA(0, 0), cA, voffA); PG8_STAGE(PG8_SB(0, 1), cB + hstep, voffB); PG8_STAGE(PG8_SA(0, 1), cA + hstep, voffA);
    if (wr == 1) PG8_BAR;
    PG8_WAIT_V(4); PG8_BAR;
    PG8_STAGE(PG8_SB(1, 0), cB + kstep, voffB); PG8_STAGE(PG8_SA(1, 0), cA + kstep, voffA); PG8_STAGE(PG8_SB(1, 1), cB + hstep + kstep, voffB);
    PG8_WAIT_V(6); PG8_BAR;
    for (;;) {
        const bool has_next = S.next(ui + 1, nxt);
        const char* nA = has_next ? (const char*)g.A + (size_t)nxt.pm * tstep : cA; const char* nB = has_next ? (const char*)g.Bt + (size_t)nxt.pn * tstep : cB;
        for (int t = 0; t < nt; t += 2) {
            const bool last = (t == nt - 2);
            const char* a1 = cA + (size_t)(t + 1) * kstep;
            const char* a2 = last ? nA : cA + (size_t)(t + 2) * kstep; const char* b2 = last ? nB : cB + (size_t)(t + 2) * kstep;
            const char* a3 = a2 + kstep; const char* b3 = b2 + kstep;
            if (last && has_next) S.a_ready(nxt);
            PG8_LDB(B0, 0, 0); PG8_SCHED; PG8_LDA(At, 0, 0); PG8_STAGE(PG8_SA(1, 1), a1 + hstep, voffA);
            PG8_WAIT_L(8); PG8_BAR; PG8_WAIT_L(0); PG8_MMA(0, 0, At, B0); PG8_BAR; PG8_SCHED;
            PG8_LDB(B1, 0, 1); PG8_STAGE(PG8_SB(0, 0), b2, voffB);
            PG8_BAR; PG8_WAIT_L(0); PG8_MMA(0, 1, At, B1); PG8_BAR;
            PG8_LDA(At, 0, 1); PG8_STAGE(PG8_SA(0, 0), a2, voffA);
            PG8_BAR; PG8_WAIT_L(0); PG8_MMA(1, 0, At, B0); PG8_BAR; PG8_SCHED;
            PG8_STAGE(PG8_SB(0, 1), b2 + hstep, voffB);
            PG8_WAIT_V(6); PG8_BAR; PG8_MMA(1, 1, At, B1); PG8_BAR;
            PG8_LDB(B0, 1, 0); PG8_SCHED; PG8_LDA(At, 1, 0); PG8_STAGE(PG8_SA(0, 1), a2 + hstep, voffA);
            PG8_WAIT_L(8); PG8_BAR; PG8_WAIT_L(0); PG8_MMA(0, 0, At, B0); PG8_BAR; PG8_SCHED;
            PG8_LDB(B1, 1, 1); PG8_STAGE(PG8_SB(1, 0), b3, voffB);
            PG8_BAR; PG8_WAIT_L(0); PG8_MMA(0, 1, At, B1); PG8_BAR;
            PG8_LDA(At, 1, 1); PG8_STAGE(PG8_SA(1, 0), a3, voffA);
            PG8_BAR; PG8_WAIT_L(0); PG8_MMA(1, 0, At, B0); PG8_BAR; PG8_SCHED;
            PG8_STAGE(PG8_SB(1, 1), b3 + hstep, voffB);
            PG8_WAIT_V(6); PG8_BAR; PG8_MMA(1, 1, At, B1); PG8_BAR;
        }
        if constexpr (!Epi::AFTER_DRAIN) { E(acc, cur, wr, wc, fr, fq); S.done(cur); }
        if (!has_next) break;
#pragma unroll
        for (int a = 0; a < 2; ++a)
#pragma unroll
            for (int b = 0; b < 2; ++b)
#pragma unroll
                for (int m = 0; m < 4; ++m)
#pragma unroll
                    for (int n = 0; n < 2; ++n) acc[a][b][m][n] = (f32x4){0.f, 0.f, 0.f, 0.f};
        cur = nxt; cA = nA; cB = nB; ++ui;
    }
    PG8_WAIT_V(0);
    if (wr == 0) PG8_BAR;
    PG8_BAR;
    if constexpr (Epi::AFTER_DRAIN) { E.fused(acc, cur, wr, wc, fr, fq, lds, wid, lane); S.done(cur); }
#undef PG8_SA
#undef PG8_SB
#undef PG8_STAGE

#undef PG8_LDA
#undef PG8_LDB
#undef PG8_MMA
#undef PG8_WAIT_V
#undef PG8_WAIT_L
#undef PG8_BAR
#undef PG8_SCHED
}

}

using pg8::ltid; using pg8::bf16_t; using pg8::bf16x8; using pg8::f32x4; using pg8::u32x4;
typedef unsigned u32x2 __attribute__((ext_vector_type(2)));
typedef PG8_LAS unsigned char* lptr;
typedef PG8_LAS float* lfptr;
namespace cg = cooperative_groups;

constexpr int NPR = 16384, NSM = 128, NRP = 16640;
constexpr int NPROJ = 4480, NPAD = 4608;
constexpr int C_MQ = 0, C_MK = 384, C_MV = 768, C_MO = 1152, C_MZ = 1536, C_RQ = 1920, C_RK = 2304, C_RV = 2688, C_RG = 3072, C_HF = 3456, C_HI = 3712, C_HQ = 3968, C_HG = 4224;
constexpr float ALPHA = 1.41421356237f;
constexpr float DH_SCALE = 0.10206207261596575f;
constexpr size_t WS_XM = 0, WS_WIN = 34078720, WS_WOUT = 52953088, WS_PROJ = 57147392, WS_GATES = 206241792, WS_UM = 206774272, WS_UR = 225648640,
                 WS_UH = 244523008, WS_NU = 252911616, WS_EG = 253304832, WS_SC = 253566976, WS_ROPE = 253583360, WS_END = 254370176, WS_BAR = 254374272;
constexpr size_t O_Y = 0, O_YS = 16777216, O_MC_P = 16908288, O_MN_P = 17498112, O_MM_P = 17504256, O_CONV_P = 17504320, O_RET_P = 17541184, O_HG_P = 18131008,
                 O_MC_S = 18393152, O_MN_S = 27830336, O_MM_S = 27928640, O_CONV_S = 27929664, O_RET_S = 28519488, O_HG_S = 37956672, O_END = 42150976;

struct Args {
    const float *x_prompt, *x_sample, *st_C, *st_n, *st_m, *st_conv, *st_ret, *st_hgrn, *w_in, *conv_w, *conv_b, *b_mgate, *m_norm_w, *r_norm_w, *h_norm_w, *hgrn_lb, *w_out, *ln_g, *ln_b;
    float* out; unsigned char* ws;
};

typedef __bf16 bf16x2_t __attribute__((ext_vector_type(2)));
typedef float f32x2_t __attribute__((ext_vector_type(2)));
__device__ __forceinline__ unsigned cvt_pk(float lo, float hi) { const f32x2_t v = {lo, hi}; const bf16x2_t b = __builtin_convertvector(v, bf16x2_t); return __builtin_bit_cast(unsigned, b); }
__device__ __forceinline__ bf16_t f2bf(float f) { return (bf16_t)(cvt_pk(f, 0.f) & 0xffffu); }
__device__ __forceinline__ float bf2f(bf16_t b) { return __uint_as_float(((unsigned)b) << 16); }
__device__ __forceinline__ float bflo(unsigned u) { return __uint_as_float(u << 16); }
__device__ __forceinline__ float bfhi(unsigned u) { return __uint_as_float(u & 0xffff0000u); }
__device__ __forceinline__ float sigmoidf_(float x) { return 1.0f / (1.0f + __expf(-x)); }
__device__ __forceinline__ float siluf_(float x) { return x / (1.0f + __expf(-x)); }
__device__ __forceinline__ float logsigmoidf_(float x) { return fminf(x, 0.f) - log1pf(__expf(-fabsf(x))); }
__device__ __forceinline__ float wave_scan_sum(float v, int lane) {
#pragma unroll
    for (int o = 1; o < 64; o <<= 1) { const float t = __shfl_up(v, o); if (lane >= o) v += t; } return v; }
__device__ __forceinline__ float wave_scan_max(float v, int lane) {
#pragma unroll
    for (int o = 1; o < 64; o <<= 1) { const float t = __shfl_up(v, o); if (lane >= o) v = fmaxf(v, t); } return v; }
__device__ __forceinline__ float wave_max(float v) {
#pragma unroll
    for (int o = 32; o; o >>= 1) v = fmaxf(v, __shfl_xor(v, o)); return v; }
__device__ __forceinline__ float wave_sum(float v) {
#pragma unroll
    for (int o = 32; o; o >>= 1) v += __shfl_xor(v, o); return v; }
template <int NK32> __device__ __forceinline__ f32x4 mma_k(lptr X, int ldx, lptr Y, int ldy, int fr, int fq, f32x4 acc) {
    lptr xp = X + fr * ldx + fq * 16; lptr yp = Y + fr * ldy + fq * 16;
#pragma unroll
    for (int k = 0; k < NK32; ++k) { const bf16x8 x = *(const PG8_LAS bf16x8*)(xp + k * 64); const bf16x8 y = *(const PG8_LAS bf16x8*)(yp + k * 64); acc = __builtin_amdgcn_mfma_f32_16x16x32_bf16(x, y, acc, 0, 0, 0); }
    return acc; }
__device__ __forceinline__ void st_tr8(lptr T, int pitch, int r0, int cbyte, u32x4 v) {
    *(PG8_LAS bf16_t*)(T + (r0 + 0) * pitch + cbyte) = (bf16_t)(v.x & 0xffff); *(PG8_LAS bf16_t*)(T + (r0 + 1) * pitch + cbyte) = (bf16_t)(v.x >> 16);
    *(PG8_LAS bf16_t*)(T + (r0 + 2) * pitch + cbyte) = (bf16_t)(v.y & 0xffff); *(PG8_LAS bf16_t*)(T + (r0 + 3) * pitch + cbyte) = (bf16_t)(v.y >> 16);
    *(PG8_LAS bf16_t*)(T + (r0 + 4) * pitch + cbyte) = (bf16_t)(v.z & 0xffff); *(PG8_LAS bf16_t*)(T + (r0 + 5) * pitch + cbyte) = (bf16_t)(v.z >> 16);
    *(PG8_LAS bf16_t*)(T + (r0 + 6) * pitch + cbyte) = (bf16_t)(v.w & 0xffff); *(PG8_LAS bf16_t*)(T + (r0 + 7) * pitch + cbyte) = (bf16_t)(v.w >> 16); }

__device__ __forceinline__ void phase_prologue(const Args& a, lptr lds) {
    const int tid = ltid();
    lfptr tile = (lfptr)lds;
    bf16_t* Win = (bf16_t*)(a.ws + WS_WIN); bf16_t* Wout = (bf16_t*)(a.ws + WS_WOUT);
    for (int it = blockIdx.x; it < 2304 + 512; it += gridDim.x) {
        const float* src; bf16_t* dst; int ld, so, nvalid, k0;
        if (it < 2304) { const int l = it / 1152, r = it % 1152, kt = r / 72, nt = r % 72, n0 = nt * 64; k0 = kt * 64;
            src = a.w_in + (size_t)l * 1024 * 4488; ld = 4488;
            if (n0 < 1920) { so = n0; nvalid = 64; } else if (n0 < 4480) { so = n0 + 8; nvalid = 64; } else if (n0 == 4480) { so = 1920; nvalid = 8; } else { so = 0; nvalid = 0; }
            dst = Win + ((size_t)l * NPAD + n0) * 1024 + k0;
        } else { const int r0 = it - 2304, l = r0 / 256, r = r0 % 256, kt = r / 16, nt = r % 16, n0 = nt * 64; k0 = kt * 64;
            src = a.w_out + (size_t)l * 1024 * 1024; ld = 1024; so = n0; nvalid = 64; dst = Wout + ((size_t)l * 1024 + n0) * 1024 + k0; }
#pragma unroll
        for (int i = 0; i < 8; ++i) { const int kk = (tid >> 6) + 8 * i, nn = tid & 63; tile[kk * 65 + nn] = nn < nvalid ? src[(size_t)(k0 + kk) * ld + so + nn] : 0.f; }
        __syncthreads();
        { const int nn = tid >> 3, kk0 = (tid & 7) * 8; float v[8];
#pragma unroll
          for (int j = 0; j < 8; ++j) v[j] = tile[(kk0 + j) * 65 + nn];
          u32x4 w; w.x = cvt_pk(v[0], v[1]); w.y = cvt_pk(v[2], v[3]); w.z = cvt_pk(v[4], v[5]); w.w = cvt_pk(v[6], v[7]);
          *(u32x4*)(dst + (size_t)nn * 1024 + kk0) = w; }
        __syncthreads();
    }
    bf16_t* XM = (bf16_t*)(a.ws + WS_XM);
    const int gt = blockIdx.x * 512 + tid, gs = gridDim.x * 512;
    for (int i = gt; i < (NPR + NSM) * 128; i += gs) { const int row = i >> 7, c8 = (i & 127) * 8;
        const float* s = row < NPR ? a.x_prompt + (size_t)row * 1024 + c8 : a.x_sample + (size_t)(row - NPR) * 1024 + c8;
        const f32x4 v0 = *(const f32x4*)s, v1 = *(const f32x4*)(s + 4);
        u32x4 w; w.x = cvt_pk(v0[0], v0[1]); w.y = cvt_pk(v0[2], v0[3]); w.z = cvt_pk(v1[0], v1[1]); w.w = cvt_pk(v1[2], v1[3]);
        *(u32x4*)(XM + (size_t)row * 1024 + c8) = w; }
    float* rope = (float*)(a.ws + WS_ROPE);
    for (int i = gt; i < 2049 * 48; i += gs) { const int p = i / 48, j = i % 48; const float pos = p < 2048 ? (float)p : 16384.0f;
        const float inv = powf(10000.0f, -(float)j / 48.0f); const float ang = pos * inv;
        const double x = (double)ang; const double n = rint(x * 0.15915494309189535); const float r = (float)(x - n * 6.283185307179586);
        rope[2 * i] = cosf(r); rope[2 * i + 1] = sinf(r); }
}

struct EpiProj {
    static constexpr bool PERM = true, AFTER_DRAIN = false;
    bf16_t* proj; float* gates;
    __device__ __forceinline__ void operator()(const f32x4 (&acc)[2][2][4][2], const pg8::Unit& u, int wr, int wc, int fr, int fq) const {
        const int row0 = u.pm * 256 + wr * 64 + fr, colb = u.pn * 256 + wc * 32 + 8 * fq;
#pragma unroll
        for (int ai = 0; ai < 2; ++ai)
#pragma unroll
            for (int m = 0; m < 4; ++m) { const int row = row0 + ai * 128 + m * 16;
#pragma unroll
                for (int bj = 0; bj < 2; ++bj) { const int c0 = colb + bj * 128; const f32x4 v0 = acc[ai][bj][m][0], v1 = acc[ai][bj][m][1];
                    if (c0 < NPROJ) { u32x4 w; w.x = cvt_pk(v0[0], v0[1]); w.y = cvt_pk(v0[2], v0[3]); w.z = cvt_pk(v1[0], v1[1]); w.w = cvt_pk(v1[2], v1[3]);
                        *(u32x4*)(proj + (size_t)row * NPROJ + c0) = w; }
                    else if (c0 == NPROJ) { *(f32x4*)(gates + (size_t)row * 8) = v0; *(f32x4*)(gates + (size_t)row * 8 + 4) = v1; } } }
    }
};
struct EpiOut {
    static constexpr bool PERM = false, AFTER_DRAIN = false;
    const float* xres; float* pre;
    __device__ __forceinline__ void operator()(const f32x4 (&acc)[2][2][4][2], const pg8::Unit& u, int wr, int wc, int fr, int fq) const {
        const int row0 = u.pm * 256 + wr * 64 + fr, col0 = u.pn * 256 + wc * 32 + 4 * fq;
#pragma unroll
        for (int ai = 0; ai < 2; ++ai)
#pragma unroll
            for (int m = 0; m < 4; ++m) { const size_t off = (size_t)(row0 + ai * 128 + m * 16) * 1024 + col0;
#pragma unroll
                for (int bj = 0; bj < 2; ++bj)
#pragma unroll
                    for (int n = 0; n < 2; ++n) { const f32x4 xr = *(const f32x4*)(xres + off + bj * 128 + n * 16); *(f32x4*)(pre + off + bj * 128 + n * 16) = xr * ALPHA + acc[ai][bj][m][n]; } }
    }
};

__device__ __forceinline__ void phase_ln(const Args& a, int layer) {
    const int tid = ltid(), wid = tid >> 6, lane = tid & 63;
    const float* pre = (const float*)(a.ws + WS_PROJ); const float* g = a.ln_g + layer * 1024; const float* bb = a.ln_b + layer * 1024;
    bf16_t* XM = (bf16_t*)(a.ws + WS_XM);
    for (int row = blockIdx.x * 8 + wid; row < NPR; row += gridDim.x * 8) {
        f32x4 v[4]; float s = 0.f;
#pragma unroll
        for (int i = 0; i < 4; ++i) { v[i] = *(const f32x4*)(pre + (size_t)row * 1024 + i * 256 + lane * 4); s += (v[i][0] + v[i][1]) + (v[i][2] + v[i][3]); }
        const float mu = wave_sum(s) * (1.0f / 1024.0f); float q = 0.f;
#pragma unroll
        for (int i = 0; i < 4; ++i) { const f32x4 d = v[i] - mu; q += (d[0] * d[0] + d[1] * d[1]) + (d[2] * d[2] + d[3] * d[3]); }
        const float rstd = rsqrtf(wave_sum(q) * (1.0f / 1024.0f) + 1e-5f);
#pragma unroll
        for (int i = 0; i < 4; ++i) { const int c = i * 256 + lane * 4; const f32x4 gg = *(const f32x4*)(g + c), b4 = *(const f32x4*)(bb + c); const f32x4 y = (v[i] - mu) * rstd * gg + b4;
            *(f32x4*)(a.out + O_Y + (size_t)row * 1024 + c) = y;
            if (layer == 0) { u32x2 w; w.x = cvt_pk(y[0], y[1]); w.y = cvt_pk(y[2], y[3]); *(u32x2*)(XM + (size_t)row * 1024 + c) = w; } }
    }
}

__device__ __forceinline__ float ret_lg(int h) { return log1pf(-exp2f(-5.0f - (float)h)); }

template <int MIX> __device__ __forceinline__ void m1_qkv(const Args& a, int layer, int it, lptr lds) {
    const int tid = ltid(), wid = tid >> 6, lane = tid & 63, fr = lane & 15, fq = lane >> 4;
    const int bh = it >> 5, c = it & 31, b = bh >> 2, h = bh & 3, row0 = b * 2048 + c * 64;
    const bf16_t* proj = (const bf16_t*)(a.ws + WS_PROJ);
    lptr KT = lds, VT = lds + 13824, RAW = lds + 27648; lfptr WV = (lfptr)(lds + 40512);
    const int kcol = (MIX == 0 ? C_MK : C_RK) + 96 * h, vcol = (MIX == 0 ? C_MV : C_RV) + 96 * h;
    constexpr int R0 = (MIX == 0) ? 3 : 0;
    for (int i = tid; i < (64 + R0) * 12; i += 512) { const int rr = i / 12, c8 = (i % 12) * 8, t = c * 64 - R0 + rr; u32x4 v = (u32x4){0u, 0u, 0u, 0u};
        if (t >= 0) v = *(const u32x4*)(proj + (size_t)(b * 2048 + t) * NPROJ + kcol + c8);
        *(PG8_LAS u32x4*)(RAW + rr * 192 + c8 * 2) = v; }
    for (int i = tid; i < 64 * 12; i += 512) { const int s = i / 12, c8 = (i % 12) * 8; const u32x4 v = *(const u32x4*)(proj + (size_t)(row0 + s) * NPROJ + vcol + c8); st_tr8(VT, 144, c8, s * 2, v); }
    float* sc = (float*)(a.ws + WS_SC);
    if (MIX == 0 && wid == 0) { const float* gt = (const float*)(a.ws + WS_GATES) + (size_t)(row0 + lane) * 8; const float* bm = a.b_mgate + layer * 8;
        const float ig = gt[h] + bm[h], lf = logsigmoidf_(gt[4 + h] + bm[4 + h]); const float bc = wave_scan_sum(lf, lane); const float G = __shfl(bc, 63);
        const float as = G - bc + ig; const float ml = wave_max(as); WV[lane] = __expf(as - ml);
        if (lane == 0) { sc[it * 4 + 0] = G; sc[it * 4 + 1] = ml; } }
    __syncthreads();
    if (MIX == 0) {
        if (tid < 480) { const int d = tid % 96, sg = tid / 96; const float* cw = a.conv_w + (size_t)layer * 4 * 768 + 384 + 96 * h + d;
            const float w0 = cw[0], w1 = cw[768], w2 = cw[1536], w3 = cw[2304], cb = a.conv_b[layer * 768 + 384 + 96 * h + d];
            for (int s = sg; s < 64; s += 5) {
                const float x0 = bf2f(*(PG8_LAS bf16_t*)(RAW + (s + 0) * 192 + d * 2)), x1 = bf2f(*(PG8_LAS bf16_t*)(RAW + (s + 1) * 192 + d * 2)),
                            x2 = bf2f(*(PG8_LAS bf16_t*)(RAW + (s + 2) * 192 + d * 2)), x3 = bf2f(*(PG8_LAS bf16_t*)(RAW + (s + 3) * 192 + d * 2));
                const float val = cb + w0 * x0 + w1 * x1 + w2 * x2 + w3 * x3;
                *(PG8_LAS bf16_t*)(KT + d * 144 + s * 2) = f2bf(siluf_(val) * WV[s] * DH_SCALE); } }
    } else {
        const float lg = ret_lg(h); const float* rope = (const float*)(a.ws + WS_ROPE);
        for (int i = tid; i < 64 * 48; i += 512) { const int s = i / 48, j = i % 48;
            const float x1 = bf2f(*(PG8_LAS bf16_t*)(RAW + s * 192 + j * 2)), x2 = bf2f(*(PG8_LAS bf16_t*)(RAW + s * 192 + (j + 48) * 2));
            const float cs = rope[((c * 64 + s) * 48 + j) * 2], sn = rope[((c * 64 + s) * 48 + j) * 2 + 1]; const float dec = __expf((float)(63 - s) * lg) * DH_SCALE;
            *(PG8_LAS bf16_t*)(KT + j * 144 + s * 2) = f2bf((x1 * cs - x2 * sn) * dec); *(PG8_LAS bf16_t*)(KT + (j + 48) * 144 + s * 2) = f2bf((x1 * sn + x2 * cs) * dec); }
    }
    __syncthreads();
    bf16_t* U = (bf16_t*)(a.ws + (MIX == 0 ? WS_UM : WS_UR)) + (size_t)it * 9216;
    for (int blk = wid; blk < 36; blk += 8) { const int vi = blk / 6, di = blk % 6;
        f32x4 acc = (f32x4){0.f, 0.f, 0.f, 0.f}; acc = mma_k<2>(KT + di * 16 * 144, 144, VT + vi * 16 * 144, 144, fr, fq, acc);
        u32x2 w; w.x = cvt_pk(acc[0], acc[1]); w.y = cvt_pk(acc[2], acc[3]); *(u32x2*)(U + (16 * vi + fr) * 96 + 16 * di + 4 * fq) = w; }
    if (MIX == 0 && tid < 96) { float s = 0.f;
#pragma unroll
        for (int k = 0; k < 8; ++k) { const u32x4 v = *(const PG8_LAS u32x4*)(KT + tid * 144 + k * 16); s += (bflo(v.x) + bfhi(v.x)) + (bflo(v.y) + bfhi(v.y)) + (bflo(v.z) + bfhi(v.z)) + (bflo(v.w) + bfhi(v.w)); }
        ((float*)(a.ws + WS_NU))[it * 96 + tid] = s; }
    __syncthreads();
}

__device__ __forceinline__ float hgrn_lb(const Args& a, int layer, int col) { return layer ? sigmoidf_(a.hgrn_lb[256 + col] - a.hgrn_lb[col]) : 0.f; }

__device__ __forceinline__ void m1_hgrn(const Args& a, int layer, int it, lptr lds) {
    const int tid = ltid(), wid = tid >> 6, lane = tid & 63, fr = lane & 15, fq = lane >> 4;
    const int bh = it >> 5, c = it & 31, b = bh >> 2, h = bh & 3, row0 = b * 2048 + c * 64;
    const bf16_t* proj = (const bf16_t*)(a.ws + WS_PROJ);
    lptr KT = lds, VT = lds + 9216; lfptr SEG = (lfptr)(lds + 18432);
    const int ch = tid & 63, seg = tid >> 6; const float lb = hgrn_lb(a, layer, 64 * h + ch);
    float kv[8], bc[8]; float run = 0.f;
#pragma unroll
    for (int i = 0; i < 8; ++i) { const float fp = bf2f(proj[(size_t)(row0 + seg * 8 + i) * NPROJ + C_HF + 64 * h + ch]); const float k = (1.0f - lb) / (1.0f + __expf(fp)); kv[i] = k; run += log1pf(-k); bc[i] = run; }
    SEG[seg * 64 + ch] = run;
    { const int s = tid >> 3, c8 = (tid & 7) * 8; const u32x4 v = *(const u32x4*)(proj + (size_t)(row0 + s) * NPROJ + C_HI + 64 * h + c8); st_tr8(VT, 144, c8, s * 2, v); }
    __syncthreads();
    float off = 0.f, tot = 0.f;
#pragma unroll
    for (int s2 = 0; s2 < 8; ++s2) { const float x = SEG[s2 * 64 + ch]; tot += x; if (s2 < seg) off += x; }
    { float o[8];
#pragma unroll
      for (int i = 0; i < 8; ++i) o[i] = kv[i] * __expf(tot - (off + bc[i]));
      u32x4 w; w.x = cvt_pk(o[0], o[1]); w.y = cvt_pk(o[2], o[3]); w.z = cvt_pk(o[4], o[5]); w.w = cvt_pk(o[6], o[7]); *(PG8_LAS u32x4*)(KT + ch * 144 + seg * 16) = w; }
    if (seg == 0) ((float*)(a.ws + WS_EG))[it * 64 + ch] = __expf(tot);
    __syncthreads();
    bf16_t* U = (bf16_t*)(a.ws + WS_UH) + (size_t)it * 4096;
    for (int blk = wid; blk < 16; blk += 8) { const int vi = blk >> 2, ci = blk & 3;
        f32x4 acc = (f32x4){0.f, 0.f, 0.f, 0.f}; acc = mma_k<2>(KT + ci * 16 * 144, 144, VT + vi * 16 * 144, 144, fr, fq, acc);
        u32x2 w; w.x = cvt_pk(acc[0], acc[1]); w.y = cvt_pk(acc[2], acc[3]); *(u32x2*)(U + (16 * vi + fr) * 64 + 16 * ci + 4 * fq) = w; }
    __syncthreads();
}

template <int K, int V> __device__ __forceinline__ void state_pass(const float* Min, float* Mout, lfptr qe, lfptr dk, lfptr kk, lfptr vv, lfptr numacc) {
    constexpr int V4 = V / 4, KG = 512 / V4; const int tid = ltid();
    if (tid < V4 * KG) { const int v4 = tid % V4, kg = tid / V4; f32x4 acc = (f32x4){0.f, 0.f, 0.f, 0.f}; const f32x4 vvv = *(const PG8_LAS f32x4*)(vv + 4 * v4);
        for (int k = kg; k < K; k += KG) { const f32x4 m = *(const f32x4*)(Min + k * V + 4 * v4); acc += m * qe[k]; *(f32x4*)(Mout + k * V + 4 * v4) = m * dk[k] + vvv * kk[k]; }
#pragma unroll
        for (int j = 0; j < 4; ++j) atomicAdd((float*)(numacc + 4 * v4 + j), acc[j]); }
}

__device__ __forceinline__ void sample_item(const Args& a, int layer, int idx, lptr lds) {
    const int tid = ltid(), lane = tid & 63;
    const int mix = idx / 512, b = (idx % 512) >> 2, h = idx & 3, row = NPR + b;
    const bf16_t* prow = (const bf16_t*)(a.ws + WS_PROJ) + (size_t)row * NPROJ; bf16_t* xm = (bf16_t*)(a.ws + WS_XM) + (size_t)row * 1024;
    lfptr qv = (lfptr)lds, kv = qv + 96, vv = kv + 96, dk = vv + 96, qe = dk + 96, numacc = qe + 96, hv = numacc + 96;
    if (mix == 0) {
        if (tid < 192) { const int col = tid < 96 ? 96 * h + tid : 384 + 96 * h + (tid - 96); const float cur = bf2f(prow[col]);
            const float* bufp = a.st_conv + ((size_t)(layer * 128 + b) * 3) * 768 + col; const float b0 = bufp[0], b1 = bufp[768], b2 = bufp[1536];
            const float* cw = a.conv_w + (size_t)layer * 4 * 768 + col; float val = a.conv_b[layer * 768 + col] + cw[0] * b0 + cw[768] * b1 + cw[1536] * b2 + cw[2304] * cur; val = siluf_(val);
            if (tid < 96) qv[tid] = val; else kv[tid - 96] = val * DH_SCALE;
            float* co = a.out + O_CONV_S + ((size_t)(layer * 128 + b) * 3) * 768 + col; co[0] = b1; co[768] = b2; co[1536] = cur; }
        else if (tid < 288) vv[tid - 192] = bf2f(prow[C_MV + 96 * h + tid - 192]);
        else if (tid < 384) numacc[tid - 288] = 0.f;
        __syncthreads();
        const float* gt = (const float*)(a.ws + WS_GATES) + (size_t)row * 8; const float* bm = a.b_mgate + layer * 8;
        const float ig = gt[h] + bm[h], lf = logsigmoidf_(gt[4 + h] + bm[4 + h]); const size_t sbh = (size_t)(layer * 128 + b) * 4 + h; const float mp = a.st_m[sbh];
        const float mt = fmaxf(ig, lf + mp), sfac = __expf(ig - mt), wpr = __expf(lf + mp - mt);
        const float* nin = a.st_n + sbh * 96;
        float pqk = qv[lane] * kv[lane], pqn = qv[lane] * nin[lane]; if (lane < 32) { pqk += qv[lane + 64] * kv[lane + 64]; pqn += qv[lane + 64] * nin[lane + 64]; }
        const float qk = wave_sum(pqk), qn = wave_sum(pqn);
        if (tid < 96) { dk[tid] = wpr; qe[tid] = qv[tid]; }
        __syncthreads();
        if (tid < 96) kv[tid] = kv[tid] * sfac;
        __syncthreads();
        state_pass<96, 96>(a.st_C + sbh * 9216, a.out + O_MC_S + sbh * 9216, qe, dk, kv, vv, numacc);
        __syncthreads();
        if (tid < 96) { const float s = qk * sfac; const float num = s * vv[tid] + wpr * numacc[tid]; const float den = s + wpr * qn; hv[tid] = num / fmaxf(fabsf(den), __expf(-mt));
            a.out[O_MN_S + sbh * 96 + tid] = wpr * nin[tid] + kv[tid]; if (tid == 0) a.out[O_MM_S + sbh] = mt; }
        __syncthreads();
        if (tid < 96) { float mu = 0.f; for (int i = 0; i < 96; ++i) mu += hv[i]; mu *= (1.0f / 96.0f); float q = 0.f; for (int i = 0; i < 96; ++i) { const float d = hv[i] - mu; q += d * d; }
            const float rstd = rsqrtf(q * (1.0f / 96.0f) + 1e-6f); const int col = 96 * h + tid;
            const float y = (hv[tid] - mu) * rstd * a.m_norm_w[layer * 384 + col] * sigmoidf_(bf2f(prow[C_MO + col])) * siluf_(bf2f(prow[C_MZ + col])); xm[col] = f2bf(y); }
    } else if (mix == 1) {
        const float lg = ret_lg(h), gam = __expf(lg); const float* rope = (const float*)(a.ws + WS_ROPE) + (size_t)2048 * 96;
        if (tid < 96) { const int which = tid / 48, j = tid % 48; const int base = (which == 0 ? C_RQ : C_RK) + 96 * h; const float x1 = bf2f(prow[base + j]), x2 = bf2f(prow[base + j + 48]);
            const float cs = rope[2 * j], sn = rope[2 * j + 1]; const float o1 = x1 * cs - x2 * sn, o2 = x1 * sn + x2 * cs;
            if (which == 0) { qv[j] = o1; qv[j + 48] = o2; } else { kv[j] = o1 * DH_SCALE; kv[j + 48] = o2 * DH_SCALE; } }
        else if (tid < 192) vv[tid - 96] = bf2f(prow[C_RV + 96 * h + tid - 96]);
        else if (tid < 288) { numacc[tid - 192] = 0.f; dk[tid - 192] = gam; }
        __syncthreads();
        float pqk = qv[lane] * kv[lane]; if (lane < 32) pqk += qv[lane + 64] * kv[lane + 64]; const float qk = wave_sum(pqk);
        const size_t sbh = (size_t)(layer * 128 + b) * 4 + h;
        state_pass<96, 96>(a.st_ret + sbh * 9216, a.out + O_RET_S + sbh * 9216, qv, dk, kv, vv, numacc);
        __syncthreads();
        if (tid < 96) hv[tid] = qk * vv[tid] + gam * numacc[tid];
        __syncthreads();
        if (tid < 96) { float mu = 0.f; for (int i = 0; i < 96; ++i) mu += hv[i]; mu *= (1.0f / 96.0f); float q = 0.f; for (int i = 0; i < 96; ++i) { const float d = hv[i] - mu; q += d * d; }
            const float rstd = rsqrtf(q * (1.0f / 96.0f) + 1e-6f); const int col = 96 * h + tid;
            const float y = (hv[tid] - mu) * rstd * a.r_norm_w[layer * 384 + col] * siluf_(bf2f(prow[C_RG + col])); xm[384 + col] = f2bf(y); }
    } else {
        if (tid < 64) { const int col = 64 * h + tid; const float lb = hgrn_lb(a, layer, col); const float fp = bf2f(prow[C_HF + col]); const float k = (1.0f - lb) / (1.0f + __expf(fp)); const float f = 1.0f - k;
            const float q = bf2f(prow[C_HQ + col]); qv[tid] = q; kv[tid] = k; dk[tid] = f; qe[tid] = q * f; vv[tid] = bf2f(prow[C_HI + col]); numacc[tid] = 0.f; }
        __syncthreads();
        const float qk = wave_sum(qv[lane] * kv[lane]);
        const size_t sbh = (size_t)(layer * 128 + b) * 4 + h;
        state_pass<64, 64>(a.st_hgrn + sbh * 4096, a.out + O_HG_S + sbh * 4096, qe, dk, kv, vv, numacc);
        __syncthreads();
        if (tid < 64) hv[tid] = qk * vv[tid] + numacc[tid];
        __syncthreads();
        if (tid < 64) { float q = 0.f; for (int i = 0; i < 64; ++i) q += hv[i] * hv[i]; const float rstd = rsqrtf(q * (1.0f / 64.0f) + 1e-6f); const int col = 64 * h + tid;
            const float y = hv[tid] * rstd * a.h_norm_w[layer * 256 + col] * siluf_(bf2f(prow[C_HG + col])); xm[768 + col] = f2bf(y); }
    }
    __syncthreads();
}

__device__ __forceinline__ void phase_m1(const Args& a, int layer, lptr lds) {
    for (int idx = blockIdx.x; idx < 3072 + 1536; idx += gridDim.x) {
        if (idx < 1024) m1_qkv<0>(a, layer, idx, lds);
        else if (idx < 2048) m1_qkv<1>(a, layer, idx - 1024, lds);
        else if (idx < 3072) m1_hgrn(a, layer, idx - 2048, lds);
        else sample_item(a, layer, idx - 3072, lds);
    }
}

__device__ __forceinline__ void ld8(const bf16_t* p, float (&u)[8]) { const u32x4 v = *(const u32x4*)p; u[0] = bflo(v.x); u[1] = bfhi(v.x); u[2] = bflo(v.y); u[3] = bfhi(v.y); u[4] = bflo(v.z); u[5] = bfhi(v.z); u[6] = bflo(v.w); u[7] = bfhi(v.w); }
__device__ __forceinline__ void st8(bf16_t* p, const float (&u)[8]) { u32x4 w; w.x = cvt_pk(u[0], u[1]); w.y = cvt_pk(u[2], u[3]); w.z = cvt_pk(u[4], u[5]); w.w = cvt_pk(u[6], u[7]); *(u32x4*)p = w; }

__device__ __forceinline__ void sample_out_ln(const Args& a, int layer, int item, lptr lds) {
    const int tid = ltid(), wid = tid >> 6, lane = tid & 63, fr = lane & 15, fq = lane >> 4;
    lptr AS = lds; lfptr PRE = (lfptr)(lds + 16 * 2064);
    bf16_t* XM = (bf16_t*)(a.ws + WS_XM) + (size_t)(NPR + 16 * item) * 1024;
    const bf16_t* W = (const bf16_t*)(a.ws + WS_WOUT) + (size_t)layer * 1024 * 1024;
    for (int i = tid; i < 16 * 128; i += 512) { const int r = i >> 7, c8 = (i & 127) * 8; *(PG8_LAS u32x4*)(AS + r * 2064 + c8 * 2) = *(const u32x4*)(XM + (size_t)r * 1024 + c8); }
    __syncthreads();
    const float* xres = (layer == 0 ? a.x_sample : a.out + O_YS) + (size_t)(16 * item) * 1024;
    for (int nb = wid; nb < 64; nb += 8) { f32x4 acc = (f32x4){0.f, 0.f, 0.f, 0.f};
        const bf16_t* wp = W + (size_t)(nb * 16 + fr) * 1024 + fq * 8; lptr ap = AS + fr * 2064 + fq * 16;
#pragma unroll 4
        for (int k = 0; k < 32; ++k) { const bf16x8 x = *(const bf16x8*)(wp + k * 32); const bf16x8 y = *(const PG8_LAS bf16x8*)(ap + k * 64); acc = __builtin_amdgcn_mfma_f32_16x16x32_bf16(x, y, acc, 0, 0, 0); }
        const int n0 = nb * 16 + 4 * fq; const f32x4 xr = *(const f32x4*)(xres + (size_t)fr * 1024 + n0);
        *(PG8_LAS f32x4*)(PRE + fr * 1028 + n0) = xr * ALPHA + acc; }
    __syncthreads();
    const float* g = a.ln_g + layer * 1024; const float* bb = a.ln_b + layer * 1024;
    for (int r = wid * 2; r < wid * 2 + 2; ++r) { f32x4 v[4]; float s = 0.f;
#pragma unroll
        for (int i = 0; i < 4; ++i) { v[i] = *(const PG8_LAS f32x4*)(PRE + r * 1028 + i * 256 + lane * 4); s += (v[i][0] + v[i][1]) + (v[i][2] + v[i][3]); }
        const float mu = wave_sum(s) * (1.0f / 1024.0f); float q = 0.f;
#pragma unroll
        for (int i = 0; i < 4; ++i) { const f32x4 d = v[i] - mu; q += (d[0] * d[0] + d[1] * d[1]) + (d[2] * d[2] + d[3] * d[3]); }
        const float rstd = rsqrtf(wave_sum(q) * (1.0f / 1024.0f) + 1e-5f);
#pragma unroll
        for (int i = 0; i < 4; ++i) { const int c = i * 256 + lane * 4; const f32x4 y = (v[i] - mu) * rstd * *(const f32x4*)(g + c) + *(const f32x4*)(bb + c);
            *(f32x4*)(a.out + O_YS + (size_t)(16 * item + r) * 1024 + c) = y;
            if (layer == 0) { u32x2 w; w.x = cvt_pk(y[0], y[1]); w.y = cvt_pk(y[2], y[3]); *(u32x2*)(XM + (size_t)r * 1024 + c) = w; } } }
    __syncthreads();
}

__device__ __forceinline__ void phase_m2(const Args& a, int layer, lptr lds) {
    const int tid = ltid(); float* sc = (float*)(a.ws + WS_SC);
    for (int task = blockIdx.x * 512 + tid; task < 93184; task += gridDim.x * 512) {
        if (task < 73728) {
            const bool isr = task >= 36864; const int t2 = isr ? task - 36864 : task; const int bh = t2 / 1152, e8 = t2 % 1152;
            bf16_t* base = (bf16_t*)(a.ws + (isr ? WS_UR : WS_UM)) + (size_t)bh * 32 * 9216 + e8 * 8;
            float C[8] = {0.f, 0.f, 0.f, 0.f, 0.f, 0.f, 0.f, 0.f}; float m = 0.f; const float g64 = __expf(64.0f * ret_lg(bh & 3));
            for (int c = 0; c < 32; ++c) { float u[8]; ld8(base + (size_t)c * 9216, u); float dC, sU;
                if (isr) { dC = g64; sU = 1.0f; } else { const float G = sc[(bh * 32 + c) * 4], ml = sc[(bh * 32 + c) * 4 + 1]; const float mn = fmaxf(G + m, ml); dC = __expf(G + m - mn); sU = __expf(ml - mn); m = mn; }
                st8(base + (size_t)c * 9216, C);
#pragma unroll
                for (int j = 0; j < 8; ++j) C[j] = dC * C[j] + sU * u[j]; }
            const int v = e8 / 12, d0 = (e8 % 12) * 8; float* o = a.out + (isr ? O_RET_P : O_MC_P) + ((size_t)layer * 32 + bh) * 9216;
#pragma unroll
            for (int j = 0; j < 8; ++j) o[(d0 + j) * 96 + v] = C[j];
        } else if (task < 90112) {
            const int t2 = task - 73728, bh = t2 / 512, e8 = t2 % 512; bf16_t* base = (bf16_t*)(a.ws + WS_UH) + (size_t)bh * 32 * 4096 + e8 * 8;
            const int v = e8 / 8, c0 = (e8 % 8) * 8; const float* eg = (const float*)(a.ws + WS_EG) + (size_t)bh * 32 * 64 + c0;
            float S[8] = {0.f, 0.f, 0.f, 0.f, 0.f, 0.f, 0.f, 0.f};
            for (int c = 0; c < 32; ++c) { float u[8]; ld8(base + (size_t)c * 4096, u); const f32x4 e0 = *(const f32x4*)(eg + c * 64), e1 = *(const f32x4*)(eg + c * 64 + 4);
                st8(base + (size_t)c * 4096, S);
#pragma unroll
                for (int j = 0; j < 4; ++j) { S[j] = e0[j] * S[j] + u[j]; S[j + 4] = e1[j] * S[j + 4] + u[j + 4]; } }
            float* o = a.out + O_HG_P + ((size_t)layer * 32 + bh) * 4096;
#pragma unroll
            for (int j = 0; j < 8; ++j) o[(c0 + j) * 64 + v] = S[j];
        } else {
            const int t3 = task - 90112, bh = t3 / 96, d = t3 % 96; float* nu = (float*)(a.ws + WS_NU) + (size_t)bh * 32 * 96 + d; float n = 0.f, m = 0.f;
            for (int c = 0; c < 32; ++c) { const float G = sc[(bh * 32 + c) * 4], ml = sc[(bh * 32 + c) * 4 + 1]; const float u = nu[c * 96]; const float mn = fmaxf(G + m, ml);
                nu[c * 96] = n; if (d == 0) sc[(bh * 32 + c) * 4 + 2] = m; n = __expf(G + m - mn) * n + __expf(ml - mn) * u; m = mn; }
            a.out[O_MN_P + ((size_t)layer * 32 + bh) * 96 + d] = n; if (d == 0) a.out[O_MM_P + layer * 32 + bh] = m;
        }
    }
    const int wb = (int)gridDim.x - 1 - (int)blockIdx.x;
    for (int item = wb; item < 8; item += gridDim.x) sample_out_ln(a, layer, item, lds);
}

template <int MIX> __device__ __forceinline__ void m3_qkv(const Args& a, int layer, int it, lptr lds) {
    const int tid = ltid(), wid = tid >> 6, lane = tid & 63, fr = lane & 15, fq = lane >> 4;
    const int bh = it >> 5, c = it & 31, b = bh >> 2, h = bh & 3, row0 = b * 2048 + c * 64;
    const bf16_t* proj = (const bf16_t*)(a.ws + WS_PROJ);
    lptr QS = lds, KS = lds + 13312, VT = lds + 26624, CT = lds + 40448, PS = lds + 60416, RAW = lds + 95232;
    lfptr HS = (lfptr)(lds + 69632); lfptr SC = (lfptr)(lds + 120960);
    lfptr rowterm = SC, gs = SC + 64, wprior = SC + 128, enm = SC + 192, rowsum = SC + 256, qn = SC + 320, nvec = SC + 384;
    constexpr int R0 = (MIX == 0) ? 3 : 0;
    const int qcol = (MIX == 0 ? C_MQ : C_RQ) + 96 * h, kcol = (MIX == 0 ? C_MK : C_RK) + 96 * h, vcol = (MIX == 0 ? C_MV : C_RV) + 96 * h;
    const float lg = ret_lg(h);
    for (int i = tid; i < (64 + R0) * 24; i += 512) { const int rr = i / 24, c8 = (i % 24) * 8, t = c * 64 - R0 + rr; u32x4 v = (u32x4){0u, 0u, 0u, 0u};
        if (t >= 0) v = *(const u32x4*)(proj + (size_t)(b * 2048 + t) * NPROJ + (c8 < 96 ? qcol + c8 : kcol + c8 - 96));
        *(PG8_LAS u32x4*)(RAW + rr * 384 + c8 * 2) = v; }
    for (int i = tid; i < 64 * 12; i += 512) { const int s = i / 12, c8 = (i % 12) * 8; const u32x4 v = *(const u32x4*)(proj + (size_t)(row0 + s) * NPROJ + vcol + c8); st_tr8(VT, 144, c8, s * 2, v); }
    { const bf16_t* U = (const bf16_t*)(a.ws + (MIX == 0 ? WS_UM : WS_UR)) + (size_t)it * 9216;
      for (int i = tid; i < 1152; i += 512) { const int v = i / 12, c8 = (i % 12) * 8; *(PG8_LAS u32x4*)(CT + v * 208 + c8 * 2) = *(const u32x4*)(U + v * 96 + c8); } }
    if (MIX == 0) {
        if (tid >= 64 && tid < 160) nvec[tid - 64] = ((const float*)(a.ws + WS_NU))[it * 96 + tid - 64];
        if (wid == 0) { const float* gt = (const float*)(a.ws + WS_GATES) + (size_t)(row0 + lane) * 8; const float* bm = a.b_mgate + layer * 8;
            const float ig = gt[h] + bm[h], lf = logsigmoidf_(gt[4 + h] + bm[4 + h]); const float bc = wave_scan_sum(lf, lane); const float g = ig - bc; const float pm = wave_scan_max(g, lane);
            const float mc = ((const float*)(a.ws + WS_SC))[it * 4 + 2]; const float M = fmaxf(pm, mc);
            rowterm[lane] = -M; gs[lane] = g; wprior[lane] = __expf(mc - M); enm[lane] = __expf(-(bc + M)); rowsum[lane] = 0.f; }
    }
    __syncthreads();
    if (MIX == 0) {
#pragma unroll
        for (int ci = 0; ci < 3; ++ci) { const int col = lane + 64 * ci; const int gcol = col < 96 ? 96 * h + col : 384 + 96 * h + col - 96;
            const float* cw = a.conv_w + (size_t)layer * 4 * 768 + gcol; const float w0 = cw[0], w1 = cw[768], w2 = cw[1536], w3 = cw[2304], cb = a.conv_b[layer * 768 + gcol];
            const float scl = col < 96 ? 1.0f : DH_SCALE; lptr dst = col < 96 ? QS + col * 2 : KS + (col - 96) * 2;
            float x0 = bf2f(*(PG8_LAS bf16_t*)(RAW + (8 * wid + 0) * 384 + col * 2)), x1 = bf2f(*(PG8_LAS bf16_t*)(RAW + (8 * wid + 1) * 384 + col * 2)), x2 = bf2f(*(PG8_LAS bf16_t*)(RAW + (8 * wid + 2) * 384 + col * 2));
#pragma unroll
            for (int i = 0; i < 8; ++i) { const int t = 8 * wid + i; const float x3 = bf2f(*(PG8_LAS bf16_t*)(RAW + (t + 3) * 384 + col * 2));
                const float val = cb + w0 * x0 + w1 * x1 + w2 * x2 + w3 * x3; *(PG8_LAS bf16_t*)(dst + t * 208) = f2bf(siluf_(val) * scl); x0 = x1; x1 = x2; x2 = x3; } }
        if (c == 31 && tid < 192) { const int gcol = tid < 96 ? 96 * h + tid : 384 + 96 * h + tid - 96; float* co = a.out + O_CONV_P + ((size_t)(layer * 8 + b) * 3) * 768 + gcol;
#pragma unroll
            for (int j = 0; j < 3; ++j) co[j * 768] = bf2f(*(PG8_LAS bf16_t*)(RAW + (64 + j) * 384 + tid * 2)); }
    } else {
        const float* rope = (const float*)(a.ws + WS_ROPE);
        for (int i = tid; i < 64 * 96; i += 512) { const int s = i / 96, jj = i % 96, which = jj / 48, j = jj % 48;
            const float x1 = bf2f(*(PG8_LAS bf16_t*)(RAW + s * 384 + (which * 96 + j) * 2)), x2 = bf2f(*(PG8_LAS bf16_t*)(RAW + s * 384 + (which * 96 + j + 48) * 2));
            const float cs = rope[((c * 64 + s) * 48 + j) * 2], sn = rope[((c * 64 + s) * 48 + j) * 2 + 1]; const float scl = which ? DH_SCALE : 1.0f; lptr dst = (which ? KS : QS) + s * 208;
            *(PG8_LAS bf16_t*)(dst + j * 2) = f2bf((x1 * cs - x2 * sn) * scl); *(PG8_LAS bf16_t*)(dst + (j + 48) * 2) = f2bf((x1 * sn + x2 * cs) * scl); }
    }
    __syncthreads();
    if (MIX == 0) { const int t = tid >> 3, part = tid & 7; float s = 0.f;
#pragma unroll
        for (int i = 0; i < 12; ++i) s += bf2f(*(PG8_LAS bf16_t*)(QS + t * 208 + (part * 12 + i) * 2)) * nvec[part * 12 + i];
        s += __shfl_xor(s, 1); s += __shfl_xor(s, 2); s += __shfl_xor(s, 4); if (part == 0) qn[t] = s; }
    { const int ti = wid >> 1;
#pragma unroll
      for (int sj = 0; sj < 2; ++sj) { const int si = 2 * (wid & 1) + sj; const int t = 16 * ti + fr, s0 = 16 * si + 4 * fq; u32x2 w = (u32x2){0u, 0u};
          if (si <= ti) { f32x4 acc = (f32x4){0.f, 0.f, 0.f, 0.f}; acc = mma_k<3>(KS + si * 16 * 208, 208, QS + ti * 16 * 208, 208, fr, fq, acc);
              float p[4];
#pragma unroll
              for (int j = 0; j < 4; ++j) { const int s = s0 + j; float dl; if (MIX == 0) dl = __expf(rowterm[t] + gs[s]); else dl = __expf((float)(t - s) * lg); p[j] = s <= t ? acc[j] * dl : 0.f; }
              if (MIX == 0) { float ps = (p[0] + p[1]) + (p[2] + p[3]); ps += __shfl_xor(ps, 16); ps += __shfl_xor(ps, 32); if (fq == 0) atomicAdd((float*)(rowsum + t), ps); }
              w.x = cvt_pk(p[0], p[1]); w.y = cvt_pk(p[2], p[3]); }
          *(PG8_LAS u32x2*)(PS + t * 144 + s0 * 2) = w; } }
    __syncthreads();
    { const int ti = wid >> 1; const int t = 16 * ti + fr;
#pragma unroll
      for (int vj = 0; vj < 3; ++vj) { const int vi = 3 * (wid & 1) + vj;
          f32x4 a1 = (f32x4){0.f, 0.f, 0.f, 0.f}, a2 = (f32x4){0.f, 0.f, 0.f, 0.f};
          a1 = mma_k<2>(VT + vi * 16 * 144, 144, PS + ti * 16 * 144, 144, fr, fq, a1);
          a2 = mma_k<3>(CT + vi * 16 * 208, 208, QS + ti * 16 * 208, 208, fr, fq, a2);
          f32x4 hq;
          if (MIX == 0) { const float wp = wprior[t]; const float den = rowsum[t] + qn[t] * wp; const float inv = 1.0f / fmaxf(fabsf(den), enm[t]); hq = (a1 + a2 * wp) * inv; }
          else { const float wp = __expf((float)(t + 1) * lg); hq = a1 + a2 * wp; }
          *(PG8_LAS f32x4*)(HS + t * 100 + 16 * vi + 4 * fq) = hq; } }
    __syncthreads();
    { const int t = tid >> 3, part = tid & 7; float hv[12]; float s = 0.f;
#pragma unroll
      for (int i = 0; i < 3; ++i) { const f32x4 x = *(const PG8_LAS f32x4*)(HS + t * 100 + part * 12 + 4 * i); hv[4 * i] = x[0]; hv[4 * i + 1] = x[1]; hv[4 * i + 2] = x[2]; hv[4 * i + 3] = x[3]; s += (x[0] + x[1]) + (x[2] + x[3]); }
      s += __shfl_xor(s, 1); s += __shfl_xor(s, 2); s += __shfl_xor(s, 4); const float mu = s * (1.0f / 96.0f); float q = 0.f;
#pragma unroll
      for (int i = 0; i < 12; ++i) { const float d = hv[i] - mu; q += d * d; }
      q += __shfl_xor(q, 1); q += __shfl_xor(q, 2); q += __shfl_xor(q, 4); const float rstd = rsqrtf(q * (1.0f / 96.0f) + 1e-6f);
      const int hc = 96 * h + part * 12; const bf16_t* pr = proj + (size_t)(row0 + t) * NPROJ; const float* nw = (MIX == 0 ? a.m_norm_w : a.r_norm_w) + layer * 384 + hc;
      bf16_t* mx = (bf16_t*)(a.ws + WS_XM) + (size_t)(row0 + t) * 1024 + (MIX == 0 ? 0 : 384) + hc;
#pragma unroll
      for (int i = 0; i < 3; ++i) { float y[4]; const u32x2 g1 = *(const u32x2*)(pr + (MIX == 0 ? C_MO : C_RG) + hc + 4 * i); float gg[4] = {bflo(g1.x), bfhi(g1.x), bflo(g1.y), bfhi(g1.y)};
          float zz[4] = {0.f, 0.f, 0.f, 0.f}; if (MIX == 0) { const u32x2 z1 = *(const u32x2*)(pr + C_MZ + hc + 4 * i); zz[0] = bflo(z1.x); zz[1] = bfhi(z1.x); zz[2] = bflo(z1.y); zz[3] = bfhi(z1.y); }
#pragma unroll
          for (int j = 0; j < 4; ++j) { const float gate = MIX == 0 ? sigmoidf_(gg[j]) * siluf_(zz[j]) : siluf_(gg[j]); y[j] = (hv[4 * i + j] - mu) * rstd * nw[4 * i + j] * gate; }
          u32x2 w; w.x = cvt_pk(y[0], y[1]); w.y = cvt_pk(y[2], y[3]); *(u32x2*)(mx + 4 * i) = w; } }
    __syncthreads();
}

__device__ __forceinline__ void m3_hgrn(const Args& a, int layer, int it, lptr lds) {
    const int tid = ltid(), wid = tid >> 6, lane = tid & 63, fr = lane & 15, fq = lane >> 4;
    const int bh = it >> 5, c = it & 31, b = bh >> 2, h = bh & 3, row0 = b * 2048 + c * 64;
    const bf16_t* proj = (const bf16_t*)(a.ws + WS_PROJ);
    lfptr BC = (lfptr)lds;
    lptr QH = lds + 16640, QT = lds + 25856, KI = lds + 35072  , VT = lds + 71936, ST = lds + 81152, PS = lds + 90368; lfptr HS = (lfptr)(lds + 99584); lfptr SEG = (lfptr)(lds + 116992);
    const int ch = tid & 63, seg = tid >> 6; const float lb = hgrn_lb(a, layer, 64 * h + ch);
    float kv[8], bc[8]; float run = 0.f;
#pragma unroll
    for (int i = 0; i < 8; ++i) { const float fp = bf2f(proj[(size_t)(row0 + seg * 8 + i) * NPROJ + C_HF + 64 * h + ch]); const float k = (1.0f - lb) / (1.0f + __expf(fp)); kv[i] = k; run += log1pf(-k); bc[i] = run; }
    SEG[seg * 64 + ch] = run;
    { const int s = tid >> 3, c8 = (tid & 7) * 8; const u32x4 v = *(const u32x4*)(proj + (size_t)(row0 + s) * NPROJ + C_HI + 64 * h + c8); st_tr8(VT, 144, c8, s * 2, v);
      *(PG8_LAS u32x4*)(ST + s * 144 + c8 * 2) = *(const u32x4*)((const bf16_t*)(a.ws + WS_UH) + (size_t)it * 4096 + s * 64 + c8);
      *(PG8_LAS u32x4*)(PS + s * 144 + c8 * 2) = (u32x4){0u, 0u, 0u, 0u}; }
    __syncthreads();
    float off = 0.f;
#pragma unroll
    for (int s2 = 0; s2 < 8; ++s2) { const float x = SEG[s2 * 64 + ch]; if (s2 < seg) off += x; }
#pragma unroll
    for (int i = 0; i < 8; ++i) { bc[i] += off; BC[(seg * 8 + i) * 65 + ch] = bc[i]; }
    __syncthreads();
    { const int ib = seg >> 1;
      const float refq = ib ? BC[(16 * ib - 1) * 65 + ch] : 0.f;
#pragma unroll
      for (int i = 0; i < 8; ++i) { const int t = seg * 8 + i; const float q = bf2f(proj[(size_t)(row0 + t) * NPROJ + C_HQ + 64 * h + ch]);
          *(PG8_LAS bf16_t*)(QH + t * 144 + ch * 2) = f2bf(q * __expf(bc[i])); *(PG8_LAS bf16_t*)(QT + t * 144 + ch * 2) = f2bf(q * __expf(bc[i] - refq)); }
      for (int ii = ib; ii < 4; ++ii) { const float ref = ii ? BC[(16 * ii - 1) * 65 + ch] : 0.f;
#pragma unroll
          for (int i = 0; i < 8; ++i) { const int s = seg * 8 + i; *(PG8_LAS bf16_t*)(KI + ii * 9216 + s * 144 + ch * 2) = f2bf(kv[i] * __expf(ref - bc[i])); } } }
    __syncthreads();
    for (int blk = wid; blk < 10; blk += 8) { int ti, si; if (blk == 0) { ti = 0; si = 0; } else if (blk < 3) { ti = 1; si = blk - 1; } else if (blk < 6) { ti = 2; si = blk - 3; } else { ti = 3; si = blk - 6; }
        f32x4 acc = (f32x4){0.f, 0.f, 0.f, 0.f}; acc = mma_k<2>(KI + ti * 9216 + si * 16 * 144, 144, QT + ti * 16 * 144, 144, fr, fq, acc);
        const int t = 16 * ti + fr, s0 = 16 * si + 4 * fq; float p[4];
#pragma unroll
        for (int j = 0; j < 4; ++j) p[j] = (s0 + j) <= t ? acc[j] : 0.f;
        u32x2 w; w.x = cvt_pk(p[0], p[1]); w.y = cvt_pk(p[2], p[3]); *(PG8_LAS u32x2*)(PS + t * 144 + s0 * 2) = w; }
    __syncthreads();
    { const int ti = wid >> 1; const int t = 16 * ti + fr;
#pragma unroll
      for (int vj = 0; vj < 2; ++vj) { const int vi = 2 * (wid & 1) + vj; f32x4 acc = (f32x4){0.f, 0.f, 0.f, 0.f};
          acc = mma_k<2>(VT + vi * 16 * 144, 144, PS + ti * 16 * 144, 144, fr, fq, acc); acc = mma_k<2>(ST + vi * 16 * 144, 144, QH + ti * 16 * 144, 144, fr, fq, acc);
          *(PG8_LAS f32x4*)(HS + t * 68 + 16 * vi + 4 * fq) = acc; } }
    __syncthreads();
    { const int t = tid >> 3, part = tid & 7; const f32x4 x0 = *(const PG8_LAS f32x4*)(HS + t * 68 + part * 8), x1 = *(const PG8_LAS f32x4*)(HS + t * 68 + part * 8 + 4);
      float q = (x0[0] * x0[0] + x0[1] * x0[1]) + (x0[2] * x0[2] + x0[3] * x0[3]) + (x1[0] * x1[0] + x1[1] * x1[1]) + (x1[2] * x1[2] + x1[3] * x1[3]);
      q += __shfl_xor(q, 1); q += __shfl_xor(q, 2); q += __shfl_xor(q, 4); const float rstd = rsqrtf(q * (1.0f / 64.0f) + 1e-6f);
      const int hc = 64 * h + part * 8; const u32x4 g = *(const u32x4*)(proj + (size_t)(row0 + t) * NPROJ + C_HG + hc); const float* nw = a.h_norm_w + layer * 256 + hc;
      const f32x4 n0 = *(const f32x4*)nw, n1 = *(const f32x4*)(nw + 4);
      u32x4 w; w.x = cvt_pk(x0[0] * rstd * n0[0] * siluf_(bflo(g.x)), x0[1] * rstd * n0[1] * siluf_(bfhi(g.x))); w.y = cvt_pk(x0[2] * rstd * n0[2] * siluf_(bflo(g.y)), x0[3] * rstd * n0[3] * siluf_(bfhi(g.y)));
      w.z = cvt_pk(x1[0] * rstd * n1[0] * siluf_(bflo(g.z)), x1[1] * rstd * n1[1] * siluf_(bfhi(g.z))); w.w = cvt_pk(x1[2] * rstd * n1[2] * siluf_(bflo(g.w)), x1[3] * rstd * n1[3] * siluf_(bfhi(g.w)));
      *(u32x4*)((bf16_t*)(a.ws + WS_XM) + (size_t)(row0 + t) * 1024 + 768 + hc) = w; }
    __syncthreads();
}

__device__ __forceinline__ void phase_m3(const Args& a, int layer, lptr lds) {
    for (int idx = blockIdx.x; idx < 3072; idx += gridDim.x) {
        if (idx < 1024) m3_qkv<0>(a, layer, idx, lds);
        else if (idx < 2048) m3_qkv<1>(a, layer, idx - 1024, lds);
        else m3_hgrn(a, layer, idx - 2048, lds);
    }
}


#ifdef DBG_NAN
__device__ __forceinline__ void scan_bf16(const void* p, size_t n, unsigned* cnt) { const unsigned short* q = (const unsigned short*)p; unsigned c = 0;
    for (size_t i = (size_t)blockIdx.x * 512 + ltid(); i < n; i += (size_t)gridDim.x * 512) c += ((q[i] & 0x7f80u) == 0x7f80u) ? 1u : 0u;
    if (c) atomicAdd(cnt, c); }
__device__ __forceinline__ void scan_f32(const void* p, size_t n, unsigned* cnt) { const unsigned* q = (const unsigned*)p; unsigned c = 0;
    for (size_t i = (size_t)blockIdx.x * 512 + ltid(); i < n; i += (size_t)gridDim.x * 512) c += ((q[i] & 0x7f800000u) == 0x7f800000u) ? 1u : 0u;
    if (c) atomicAdd(cnt, c); }
__device__ __forceinline__ void dbg_scan(const Args& a, int ph, int layer, int sub) {
    unsigned* cnt = (unsigned*)(a.ws + WS_END) + ph;
    if (sub == -1) { scan_bf16(a.ws + WS_XM, (size_t)16512 * 1024, cnt); scan_bf16(a.ws + WS_WIN, (size_t)2 * NPAD * 1024, cnt); scan_bf16(a.ws + WS_WOUT, (size_t)2 * 1024 * 1024, cnt); scan_f32(a.ws + WS_ROPE, 2049 * 96, cnt); }
    else if (sub == 0) { scan_bf16(a.ws + WS_PROJ, (size_t)16512 * NPROJ, cnt); scan_f32(a.ws + WS_GATES, 16512 * 8, cnt); }
    else if (sub == 1 && layer == 0) { unsigned* c2 = (unsigned*)(a.ws + WS_END) + 16; scan_bf16(a.ws + WS_UM, (size_t)1024 * 9216, c2 + 1); scan_bf16(a.ws + WS_UR, (size_t)1024 * 9216, c2 + 2); scan_bf16(a.ws + WS_UH, (size_t)1024 * 4096, c2 + 3);
        scan_f32(a.ws + WS_NU, 1024 * 96, c2 + 4); scan_f32(a.ws + WS_EG, 1024 * 64, c2 + 5); scan_bf16(a.ws + WS_XM + (size_t)NPR * 2048, 128 * 1024, c2 + 6);
        scan_f32(a.out + O_MC_S + (size_t)layer * 128 * 4 * 9216, (size_t)128 * 4 * 9216, c2 + 7); scan_f32(a.out + O_RET_S + (size_t)layer * 128 * 4 * 9216, (size_t)128 * 4 * 9216, c2 + 8); scan_f32(a.out + O_HG_S + (size_t)layer * 128 * 4 * 4096, (size_t)128 * 4 * 4096, c2 + 9);
        { const unsigned short* q = (const unsigned short*)(a.ws + WS_PROJ); unsigned c = 0; for (size_t i = (size_t)blockIdx.x * 512 + ltid(); i < (size_t)16512 * NPROJ; i += (size_t)gridDim.x * 512) c += ((q[i] & 0x7f80u) >= 0x4300u) ? 1u : 0u; if (c) atomicAdd(c2 + 10, c); } }
    else if (sub == 2) { scan_bf16(a.ws + WS_UM, (size_t)1024 * 9216, cnt); scan_bf16(a.ws + WS_UR, (size_t)1024 * 9216, cnt); scan_bf16(a.ws + WS_UH, (size_t)1024 * 4096, cnt);
        scan_f32(a.ws + WS_NU, 1024 * 96, cnt); scan_bf16(a.ws + WS_XM + (size_t)NPR * 2048, 128 * 1024, cnt); scan_f32(a.out + O_YS, 128 * 1024, cnt); scan_f32(a.out + O_MC_P, O_MC_S - O_MC_P, cnt); }
    else if (sub == 3) { scan_bf16(a.ws + WS_XM, (size_t)NPR * 1024, cnt); }
    else if (sub == 4) { scan_f32(a.ws + WS_PROJ, (size_t)NPR * 1024, cnt); }
    else { scan_f32(a.out + O_Y, (size_t)NPR * 1024, cnt); }
}
#endif

#ifdef DBG_G1
__device__ __forceinline__ void dbg_g1(const Args& a) {
    unsigned* mx = (unsigned*)(a.ws + WS_END) + 40; const bf16_t* proj = (const bf16_t*)(a.ws + WS_PROJ); const float* gates = (const float*)(a.ws + WS_GATES);
    for (unsigned idx = blockIdx.x * 512 + ltid(); idx < 16384u; idx += gridDim.x * 512) {
        const unsigned h1 = idx * 2654435761u, h2 = (idx ^ 0x5bd1e995u) * 2246822519u; const int r = (int)((h1 >> 8) % 16512u), c = (int)((h2 >> 8) % 4488u);
        const float* xr = r < NPR ? a.x_prompt + (size_t)r * 1024 : a.x_sample + (size_t)(r - NPR) * 1024; float dot = 0.f;
        for (int k = 0; k < 1024; ++k) dot += xr[k] * a.w_in[(size_t)k * 4488 + c];
        const int n = c < 1920 ? c : (c < 1928 ? 4480 + (c - 1920) : c - 8);
        const float val = n < 4480 ? bf2f(proj[(size_t)r * NPROJ + n]) : gates[(size_t)r * 8 + n - 4480];
        float d = fabsf(val - dot); if (!(d == d)) d = 1e30f; atomicMax(mx, __float_as_uint(d)); }
}
#endif
#define XB_TMO      128
#define XB_XCNT(j)  (256  + 64 * (j))
#define XB_XSUB(j)  (1280 + 64 * (j))
#define XB_XGEN(j)  (2304 + 64 * (j))
#define XB_TOP      3328
#define XB_TOPGEN   3392
#define XCD_BAR_WORDS 3456
#define XB_SPIN_CAP (1u << 18)
#define LAS __attribute__((address_space(3)))


__device__ __forceinline__ unsigned xb_ld(unsigned* p)              { return __hip_atomic_load(p, __ATOMIC_RELAXED, __HIP_MEMORY_SCOPE_AGENT); }
__device__ __forceinline__ unsigned xb_add(unsigned* p, unsigned v) { return __hip_atomic_fetch_add(p, v, __ATOMIC_RELAXED, __HIP_MEMORY_SCOPE_AGENT); }
__device__ __forceinline__ unsigned xb_xcc_id() { return (unsigned)__builtin_amdgcn_s_getreg((3 << 11) | 20) & 0xFu; }
#define XB_SPIN(cond, bar) do { unsigned _sp = 0; while (cond) { __builtin_amdgcn_s_sleep(1); \
    if ((++_sp & 255u) == 0u) { if (xb_ld(&(bar)[XB_TMO])) break; if (_sp > XB_SPIN_CAP) { atomicAdd(&(bar)[XB_TMO], 1u); break; } } } } while (0)

struct XcdBarrier {
    unsigned* bar; unsigned x;
    volatile LAS unsigned* st;
};

__device__ __forceinline__ XcdBarrier xcd_barrier_post(unsigned* bar, volatile LAS unsigned* st) {
    XcdBarrier b; b.bar = bar; b.x = xb_xcc_id(); b.st = st;
    if (threadIdx.x == 0) (void)xb_add(&bar[XB_XCNT(b.x)], 1u);
    return b;
}
__device__ __forceinline__ void xcd_barrier_complete(unsigned* bar, unsigned x, unsigned& nloc, unsigned& nx) {
    const unsigned G = gridDim.x * gridDim.y * gridDim.z;
    unsigned sum, cnt, mine, sp = 0u;
    for (;;) {
        sum = 0u; cnt = 0u; mine = 0u;
#pragma unroll
        for (unsigned j = 0; j < 16; ++j) { const unsigned c = xb_ld(&bar[XB_XCNT(j)]); sum += c; cnt += (c > 0u) ? 1u : 0u; mine = (j == x) ? c : mine; }
        if (sum == G) break;
        __builtin_amdgcn_s_sleep(1);
        if ((++sp & 255u) == 0u) { if (xb_ld(&bar[XB_TMO])) break; if (sp > XB_SPIN_CAP) { atomicAdd(&bar[XB_TMO], 1u); break; } }
    }
    nloc = mine > 0u ? mine : 1u; nx = cnt > 0u ? cnt : 1u;
}

__device__ __forceinline__ void xcd_barrier(const XcdBarrier& b) {
    asm volatile("s_waitcnt vmcnt(0)" ::: "memory");
    __syncthreads();
    if (threadIdx.x == 0) {
        unsigned* bar = b.bar;
        __builtin_amdgcn_s_waitcnt(0);
        unsigned nloc = b.st[0], nx = b.st[1];
        if (nloc == 0u) { xcd_barrier_complete(bar, b.x, nloc, nx); b.st[0] = nloc; b.st[1] = nx; }
        const unsigned old = xb_add(&bar[XB_XSUB(b.x)], 1u);
        const unsigned gen = old / nloc;
        if (old + 1u == (gen + 1u) * nloc) {
            __builtin_amdgcn_fence(__ATOMIC_RELEASE, "agent");
            asm volatile("s_waitcnt vmcnt(0)" ::: "memory");
            const unsigned og = xb_add(&bar[XB_TOP], 1u);
            const unsigned tg = og / nx;
            if (og + 1u == (tg + 1u) * nx) xb_add(&bar[XB_TOPGEN], 1u);
            else XB_SPIN(xb_ld(&bar[XB_TOPGEN]) == tg, bar);
            __builtin_amdgcn_fence(__ATOMIC_ACQUIRE, "agent");
            xb_add(&bar[XB_XGEN(b.x)], 1u);
            asm volatile("s_waitcnt vmcnt(0)" ::: "memory");
        } else {
            XB_SPIN(xb_ld(&bar[XB_XGEN(b.x)]) == gen, bar);
            __builtin_amdgcn_fence(__ATOMIC_ACQUIRE, "agent");
            asm volatile("s_waitcnt vmcnt(0)" ::: "memory");
        }
    }
    __syncthreads();
}


#define gsync(grid) xcd_barrier(xb)
__global__ void __launch_bounds__(512) hybrid_fwd(Args a) {
    extern __shared__ __attribute__((aligned(16))) unsigned char smem[];
    lptr lds = (lptr)smem;
    cg::grid_group grid = cg::this_grid();
    if (a.ws == nullptr) grid.sync();
    volatile LAS unsigned* xst = (volatile LAS unsigned*)(lds + 131072);
    if (threadIdx.x < 4) xst[threadIdx.x] = 0u;
    __syncthreads();
    const XcdBarrier xb = xcd_barrier_post((unsigned*)(a.ws + WS_BAR), xst);
#ifdef DBG_TA
    if (blockIdx.x == 0 && ltid() == 0) ((unsigned long long*)(a.ws + WS_END + 1024))[0] = __builtin_amdgcn_s_memrealtime();
#endif
#if defined(DBG_NAN) || defined(DBG_G1)
    if (blockIdx.x == 0 && ltid() < 64) ((unsigned*)(a.ws + WS_END))[ltid()] = 0u;
#endif
    int rep = 0; (void)rep;
#pragma nounroll
    for (int ph = 0; ph < 13; ++ph) {
        const int layer = ph > 6 ? 1 : 0; const int sub = ph == 0 ? -1 : (ph - 1) % 6;
        if (sub == -1) phase_prologue(a, lds);
        else if (sub == 0) { pg8::Gemm g; g.A = (const bf16_t*)(a.ws + WS_XM); g.Bt = (const bf16_t*)(a.ws + WS_WIN) + (size_t)layer * NPAD * 1024; g.M = NRP; g.N = NPAD; g.K = 1024;
            pg8::StaticOrder S; S.init(g.M, g.N, (int)gridDim.x, (int)blockIdx.x);
            EpiProj E; E.proj = (bf16_t*)(a.ws + WS_PROJ); E.gates = (float*)(a.ws + WS_GATES);
            pg8::gemm_phase<EpiProj, pg8::StaticOrder>(lds, g, S, E); }
        else if (sub == 1) phase_m1(a, layer, lds);
        else if (sub == 2) phase_m2(a, layer, lds);
        else if (sub == 3) phase_m3(a, layer, lds);
        else if (sub == 4) { pg8::Gemm g; g.A = (const bf16_t*)(a.ws + WS_XM); g.Bt = (const bf16_t*)(a.ws + WS_WOUT) + (size_t)layer * 1024 * 1024; g.M = NPR; g.N = 1024; g.K = 1024;
            pg8::StaticOrder S; S.init(g.M, g.N, (int)gridDim.x, (int)blockIdx.x);
            EpiOut E; E.xres = layer == 0 ? a.x_prompt : a.out + O_Y; E.pre = (float*)(a.ws + WS_PROJ);
            pg8::gemm_phase<EpiOut, pg8::StaticOrder>(lds, g, S, E); }
        else phase_ln(a, layer);
#ifdef DBG_NAN
        gsync(grid); dbg_scan(a, ph, layer, sub); gsync(grid);
#elif defined(DBG_G1)
        gsync(grid); if (ph == 1) { dbg_g1(a); gsync(grid); break; }
#elif defined(REP_MASK)
        if (ph < 12 || rep == 0) gsync(grid);
        if (rep == 0 && ((REP_MASK >> (sub + 1)) & 1)) { rep = 1; --ph; } else rep = 0;
#elif defined(DBG_TA)
        gsync(grid); if (blockIdx.x == 0 && ltid() == 0) ((unsigned long long*)(a.ws + WS_END + 1024))[ph + 1] = __builtin_amdgcn_s_memrealtime();
#else
        if (ph < 12) gsync(grid);
#endif
    }
#ifdef DBG_TA
    { const unsigned long long* ts = (const unsigned long long*)(a.ws + WS_END + 1024);
      const float tb = (float)(ts[DBG_TB + 1] - ts[DBG_TB]) * 0.01f, ta = (float)(ts[DBG_TA + 1] - ts[DBG_TA]) * 0.01f;
      gsync(grid);
      for (size_t i = (size_t)blockIdx.x * 512 + ltid(); i < O_END; i += (size_t)gridDim.x * 512) a.out[i] = i < O_YS ? 1.0e3f * tb : 0.f;
      gsync(grid);
      if (blockIdx.x == 0 && ltid() == 0) a.out[O_MC_S] = 1.0e4f * ta; }
#endif
#ifdef DBG_G1
    for (size_t i = (size_t)blockIdx.x * 512 + ltid(); i < O_END; i += (size_t)gridDim.x * 512) a.out[i] = 0.f;
    gsync(grid);
    if (blockIdx.x == 0 && ltid() == 0) a.out[0] = 1.0e6f * __uint_as_float(((const unsigned*)(a.ws + WS_END))[40]);
#endif
#ifdef DBG_NAN
    for (size_t i = (size_t)blockIdx.x * 512 + ltid(); i < O_END; i += (size_t)gridDim.x * 512) a.out[i] = 0.f;
    gsync(grid);
    if (blockIdx.x == 0 && ltid() == 0) { const unsigned* cnt = (const unsigned*)(a.ws + WS_END); a.out[0] = 1.0e5f * (float)((cnt[17] ? 1 : 0) + (cnt[18] ? 2 : 0) + (cnt[19] ? 4 : 0)) + 1.0e4f * (float)((cnt[20] ? 1 : 0) + (cnt[21] ? 2 : 0) + (cnt[22] ? 4 : 0)); }
#endif
}

extern "C" void kernel_launch(void* const* d_in, const int* in_sizes, int n_in, void* d_out, int out_size, void* d_ws, size_t ws_size, hipStream_t stream) {
    static int grid = 0;
    constexpr int LDSB = 131072 + 64;
    if (!grid) {
        int dev = 0, cus = 0, per_cu = 0;
        (void)hipGetDevice(&dev);
        (void)hipDeviceGetAttribute(&cus, hipDeviceAttributeMultiprocessorCount, dev);
        (void)hipFuncSetAttribute((const void*)hybrid_fwd, hipFuncAttributeMaxDynamicSharedMemorySize, LDSB);
        (void)hipOccupancyMaxActiveBlocksPerMultiprocessor(&per_cu, (const void*)hybrid_fwd, 512, LDSB);
        if (per_cu < 1) per_cu = 1;
        grid = cus * per_cu;
        if (n_in != 19 || out_size != (int)O_END || ws_size < WS_END) fprintf(stderr, "kernel_launch: unexpected sizes n_in %d out %d ws %zu\n", n_in, out_size, ws_size);
        fprintf(stderr, "kernel_launch: grid %d (cus %d x %d)\n", grid, cus, per_cu);
    }
    (void)hipMemsetAsync((unsigned char*)d_ws + WS_BAR, 0, XCD_BAR_WORDS * 4, stream);
    Args a{};
    a.x_prompt = (const float*)d_in[0]; a.x_sample = (const float*)d_in[1]; a.st_C = (const float*)d_in[2]; a.st_n = (const float*)d_in[3]; a.st_m = (const float*)d_in[4];
    a.st_conv = (const float*)d_in[5]; a.st_ret = (const float*)d_in[6]; a.st_hgrn = (const float*)d_in[7]; a.w_in = (const float*)d_in[8]; a.conv_w = (const float*)d_in[9];
    a.conv_b = (const float*)d_in[10]; a.b_mgate = (const float*)d_in[11]; a.m_norm_w = (const float*)d_in[12]; a.r_norm_w = (const float*)d_in[13]; a.h_norm_w = (const float*)d_in[14];
    a.hgrn_lb = (const float*)d_in[15]; a.w_out = (const float*)d_in[16]; a.ln_g = (const float*)d_in[17]; a.ln_b = (const float*)d_in[18];
    a.out = (float*)d_out; a.ws = (unsigned char*)d_ws;
    void* args[] = {&a};
    hipError_t e = hipLaunchCooperativeKernel((const void*)hybrid_fwd, dim3(grid), dim3(512), args, LDSB, stream);
    if (e != hipSuccess) fprintf(stderr, "cooperative launch failed: %s (grid %d)\n", hipGetErrorString(e), grid);
}
```

```cpp
#include <hip/hip_runtime.h>
#include <hip/hip_cooperative_groups.h>
#include <cstdio>
namespace pg8 {
#define PG8_LAS __attribute__((address_space(3)))
typedef unsigned short bf16_t;
typedef short bf16x8 __attribute__((ext_vector_type(8)));
typedef float f32x4 __attribute__((ext_vector_type(4)));
typedef unsigned u32x4 __attribute__((ext_vector_type(4)));
constexpr int BM = 256, BK = 64, HALF = 128, HTB = HALF * BK * 2  , STAGE_BYTES = 8 * HTB, NXCD = 8, WGM = 8;


__device__ __forceinline__ int ltid() { int t = threadIdx.x; asm volatile("" : "+v"(t)); return t; }
__host__ __device__ __forceinline__ int lds_byte(int r, int c) { const int st = (r >> 4) * 2 + (c >> 5), rr = r & 15, cc = c & 31, ob = rr * 64 + cc * 2; return st * 1024 + (ob ^ (((ob >> 9) & 1) << 5)); }
__host__ __device__ __forceinline__ void stage_rc(int b, int& R, int& C) { const int st = b / 1024, sb = b % 1024, swz = sb ^ (((sb >> 9) & 1) << 5); R = (st >> 1) * 16 + swz / 64; C = (st & 1) * 32 + (swz % 64) / 2; }
__host__ __device__ __forceinline__ int perm32(int rho) { const int n = rho >> 4, i = rho & 15; return 8 * (i >> 2) + 4 * n + (i & 3); }

struct Unit { int pm, pn; };
struct Gemm { const bf16_t* A; const bf16_t* Bt; int M, N, K; };
struct StaticOrder {
    int nM, nN, nwg, G, c;
    __host__ __device__ void init(int M, int N, int G_, int c_) { nM = M / BM; nN = N / BM; nwg = nM * nN; G = G_; c = c_; }
    __host__ __device__ bool next(int i, Unit& u) const {
        const long L = (long)i * G + c; if (L >= nwg) return false;
        int wgid = (int)L; { const int q = nwg / NXCD, r = nwg % NXCD, xcd = wgid % NXCD, off = wgid / NXCD; wgid = (xcd < r ? xcd * (q + 1) : r * (q + 1) + (xcd - r) * q) + off; }
        const int nig = WGM * nN, gid = wgid / nig, fm = gid * WGM, gsz = (nM - fm) < WGM ? (nM - fm) : WGM;
        u.pm = fm + ((wgid % nig) % gsz); u.pn = (wgid % nig) / gsz; return true;
    }
    __device__ __forceinline__ void a_ready(const Unit&) const {}
    __device__ __forceinline__ void done(const Unit&) const {}
};

template <class Epi, class Sched>
__device__ __forceinline__ void gemm_phase(PG8_LAS unsigned char* lds, const Gemm g, const Sched& S, const Epi& E) {
    const int tid = ltid(), wid = __builtin_amdgcn_readfirstlane(tid >> 6), lane = tid & 63, wr = wid >> 2, wc = wid & 3, fr = lane & 15, fq = lane >> 4;
    const int K = g.K, nt = K / BK;
    unsigned voffA[2], voffB[2];
#pragma unroll
    for (int i = 0; i < 2; ++i) { int R, C; stage_rc(tid * 16 + i * 8192, R, C); const int Rb = Epi::PERM ? ((R & ~31) + perm32(R & 31)) : R;
        voffA[i] = (unsigned)(R * K + C) * 2u; voffB[i] = (unsigned)(Rb * K + C) * 2u; }
    const size_t kstep = (size_t)(BK * 2);
    const size_t hstep = (size_t)HALF * K * 2;
    const size_t tstep = 2 * hstep;
    const unsigned ldsw = (unsigned)wid * 1024u;
    const int aoff = lds_byte(wr * 64 + fr, fq * 8), boff = lds_byte(wc * 32 + fr, fq * 8);
#define PG8_SA(b, h) (((b) * 2 + (h)) * HTB)
#define PG8_SB(b, h) ((4 + (b) * 2 + (h)) * HTB)
#define PG8_STAGE(bufoff, gbase, voff) do { _Pragma("unroll") for (int _i = 0; _i < 2; ++_i) \
        __builtin_amdgcn_global_load_lds((const unsigned*)((const char*)(gbase) + (voff)[_i]), (PG8_LAS unsigned*)(lds + (bufoff) + ldsw + _i * 8192), 16, 0, 0); } while (0)
#define PG8_LDA(dst, b, h) do { _Pragma("unroll") for (int m = 0; m < 4; ++m) _Pragma("unroll") for (int k = 0; k < 2; ++k) dst[m][k] = *(const PG8_LAS bf16x8*)(lds + PG8_SA(b, h) + aoff + m * 2048 + k * 1024); } while (0)
#define PG8_LDB(dst, b, h) do { _Pragma("unroll") for (int n = 0; n < 2; ++n) _Pragma("unroll") for (int k = 0; k < 2; ++k) dst[n][k] = *(const PG8_LAS bf16x8*)(lds + PG8_SB(b, h) + boff + n * 2048 + k * 1024); } while (0)
#define PG8_MMA(ai, bj, At, Bt) do { __builtin_amdgcn_s_setprio(1); _Pragma("unroll") for (int m = 0; m < 4; ++m) _Pragma("unroll") for (int n = 0; n < 2; ++n) _Pragma("unroll") for (int k = 0; k < 2; ++k) \
        acc[ai][bj][m][n] = __builtin_amdgcn_mfma_f32_16x16x32_bf16(Bt[n][k], At[m][k], acc[ai][bj][m][n], 0, 0, 0); __builtin_amdgcn_s_setprio(0); } while (0)
#define PG8_WAIT_V(n) asm volatile("s_waitcnt vmcnt(" #n ")" ::: "memory")
#define PG8_WAIT_L(n) asm volatile("s_waitcnt lgkmcnt(" #n ")" ::: "memory")
#define PG8_BAR __builtin_amdgcn_s_barrier()
#define PG8_SCHED __builtin_amdgcn_sched_barrier(0)
    Unit cur, nxt; int ui = 0;
    if (!S.next(0, cur)) return;
    f32x4 acc[2][2][4][2];
#pragma unroll
    for (int a = 0; a < 2; ++a)
#pragma unroll
        for (int b = 0; b < 2; ++b)
#pragma unroll
            for (int m = 0; m < 4; ++m)
#pragma unroll
                for (int n = 0; n < 2; ++n) acc[a][b][m][n] = (f32x4){0.f, 0.f, 0.f, 0.f};
    bf16x8 At[4][2], B0[2][2], B1[2][2];
    const char* cA = (const char*)g.A + (size_t)cur.pm * tstep; const char* cB = (const char*)g.Bt + (size_t)cur.pn * tstep;
    S.a_ready(cur);
    PG8_STAGE(PG8_SB(0, 0), cB, voffB); PG8_STAGE(PG8_SA(0, 0), cA, voffA); PG8_STAGE(PG8_SB(0, 1), cB + hstep, voffB); PG8_STAGE(PG8_SA(0, 1), cA + hstep, voffA);
    if (wr == 1) PG8_BAR;
    PG8_WAIT_V(4); PG8_BAR;
    PG8_STAGE(PG8_SB(1, 0), cB + kstep, voffB); PG8_STAGE(PG8_SA(1, 0), cA + kstep, voffA); PG8_STAGE(PG8_SB(1, 1), cB + hstep + kstep, voffB);
    PG8_WAIT_V(6); PG8_BAR;
    for (;;) {
        const bool has_next = S.next(ui + 1, nxt);
        const char* nA = has_next ? (const char*)g.A + (size_t)nxt.pm * tstep : cA; const char* nB = has_next ? (const char*)g.Bt + (size_t)nxt.pn * tstep : cB;
        for (int t = 0; t < nt; t += 2) {
            const bool last = (t == nt - 2);
            const char* a1 = cA + (size_t)(t + 1) * kstep;
            const char* a2 = last ? nA : cA + (size_t)(t + 2) * kstep; const char* b2 = last ? nB : cB + (size_t)(t + 2) * kstep;
            const char* a3 = a2 + kstep; const char* b3 = b2 + kstep;
            if (last && has_next) S.a_ready(nxt);
            PG8_LDB(B0, 0, 0); PG8_SCHED; PG8_LDA(At, 0, 0); PG8_STAGE(PG8_SA(1, 1), a1 + hstep, voffA);
            PG8_WAIT_L(8); PG8_BAR; PG8_WAIT_L(0); PG8_MMA(0, 0, At, B0); PG8_BAR; PG8_SCHED;
            PG8_LDB(B1, 0, 1); PG8_STAGE(PG8_SB(0, 0), b2, voffB);
            PG8_BAR; PG8_WAIT_L(0); PG8_MMA(0, 1, At, B1); PG8_BAR;
            PG8_LDA(At, 0, 1); PG8_STAGE(PG8_SA(0, 0), a2, voffA);
            PG8_BAR; PG8_WAIT_L(0); PG8_MMA(1, 0, At, B0); PG8_BAR; PG8_SCHED;
            PG8_STAGE(PG8_SB(0, 1), b2 + hstep, voffB);
            PG8_WAIT_V(6); PG8_BAR; PG8_MMA(1, 1, At, B1); PG8_BAR;
            PG8_LDB(B0, 1, 0); PG8_SCHED; PG8_LDA(At, 1, 0); PG8_STAGE(PG8_SA(0, 1), a2 + hstep, voffA);
            PG8_WAIT_L(8); PG8_BAR; PG8_WAIT_L(0); PG8_MMA(0, 0, At, B0); PG8_BAR; PG8_SCHED;
            PG8_LDB(B1, 1, 1); PG8_STAGE(PG8_SB(1, 0), b3, voffB);
            PG8_BAR; PG8_WAIT_L(0); PG8_MMA(0, 1, At, B1); PG8_BAR;
            PG8_LDA(At, 1, 1); PG8_STAGE(PG8_SA(1, 0), a3, voffA);
            PG8_BAR; PG8_WAIT_L(0); PG8_MMA(1, 0, At, B0); PG8_BAR; PG8_SCHED;
            PG8_STAGE(PG8_SB(1, 1), b3 + hstep, voffB);
            PG8_WAIT_V(6); PG8_BAR; PG8_MMA(1, 1, At, B1); PG8_BAR;
        }
        if constexpr (!Epi::AFTER_DRAIN) { E(acc, cur, wr, wc, fr, fq); S.done(cur); }
        if (!has_next) break;
#pragma unroll
        for (int a = 0; a < 2; ++a)
#pragma unroll
            for (int b = 0; b < 2; ++b)
#pragma unroll
                for (int m = 0; m < 4; ++m)
#pragma unroll
                    for (int n = 0; n < 2; ++n) acc[a][b][m][n] = (f32x4){0.f, 0.f, 0.f, 0.f};
        cur = nxt; cA = nA; cB = nB; ++ui;
    }
    PG8_WAIT_V(0);
    if (wr == 0) PG8_BAR;
    PG8_BAR;
    if constexpr (Epi::AFTER_DRAIN) { E.fused(acc, cur, wr, wc, fr, fq, lds, wid, lane); S.done(cur); }
#undef PG8_SA
#undef PG8_SB
#undef PG8_STAGE

#undef PG8_LDA
#undef PG8_LDB
#undef PG8_MMA
#undef PG8_WAIT_V
#undef PG8_WAIT_L
#undef PG8_BAR
#undef PG8_SCHED
}

}

using pg8::ltid; using pg8::bf16_t; using pg8::bf16x8; using pg8::f32x4; using pg8::u32x4;
typedef unsigned u32x2 __attribute__((ext_vector_type(2)));
typedef PG8_LAS unsigned char* lptr;
typedef PG8_LAS float* lfptr;
namespace cg = cooperative_groups;

constexpr int NPR = 16384, NSM = 128, NRP = 16640;
constexpr int NPROJ = 4480, NPAD = 4608;
constexpr int C_MQ = 0, C_MK = 384, C_MV = 768, C_MO = 1152, C_MZ = 1536, C_RQ = 1920, C_RK = 2304, C_RV = 2688, C_RG = 3072, C_HF = 3456, C_HI = 3712, C_HQ = 3968, C_HG = 4224;
constexpr float ALPHA = 1.41421356237f;
constexpr float DH_SCALE = 0.10206207261596575f;
constexpr size_t WS_XM = 0, WS_WIN = 34078720, WS_WOUT = 52953088, WS_PROJ = 57147392, WS_GATES = 206241792, WS_UM = 206774272, WS_UR = 225648640,
                 WS_UH = 244523008, WS_NU = 252911616, WS_EG = 253304832, WS_SC = 253566976, WS_ROPE = 253583360, WS_END = 254370176, WS_BAR = 254374272, WS_PRES = 254390272;
constexpr size_t O_Y = 0, O_YS = 16777216, O_MC_P = 16908288, O_MN_P = 17498112, O_MM_P = 17504256, O_CONV_P = 17504320, O_RET_P = 17541184, O_HG_P = 18131008,
                 O_MC_S = 18393152, O_MN_S = 27830336, O_MM_S = 27928640, O_CONV_S = 27929664, O_RET_S = 28519488, O_HG_S = 37956672, O_END = 42150976;

struct Args {
    const float *x_prompt, *x_sample, *st_C, *st_n, *st_m, *st_conv, *st_ret, *st_hgrn, *w_in, *conv_w, *conv_b, *b_mgate, *m_norm_w, *r_norm_w, *h_norm_w, *hgrn_lb, *w_out, *ln_g, *ln_b;
    float* out; unsigned char* ws;
};

typedef __bf16 bf16x2_t __attribute__((ext_vector_type(2)));
typedef float f32x2_t __attribute__((ext_vector_type(2)));
__device__ __forceinline__ unsigned cvt_pk(float lo, float hi) { const f32x2_t v = {lo, hi}; const bf16x2_t b = __builtin_convertvector(v, bf16x2_t); return __builtin_bit_cast(unsigned, b); }
__device__ __forceinline__ bf16_t f2bf(float f) { return (bf16_t)(cvt_pk(f, 0.f) & 0xffffu); }
__device__ __forceinline__ float bf2f(bf16_t b) { return __uint_as_float(((unsigned)b) << 16); }
__device__ __forceinline__ float bflo(unsigned u) { return __uint_as_float(u << 16); }
__device__ __forceinline__ float bfhi(unsigned u) { return __uint_as_float(u & 0xffff0000u); }
__device__ __forceinline__ float sigmoidf_(float x) { return 1.0f / (1.0f + __expf(-x)); }
__device__ __forceinline__ float siluf_(float x) { return x / (1.0f + __expf(-x)); }
__device__ __forceinline__ float logsigmoidf_(float x) { return fminf(x, 0.f) - log1pf(__expf(-fabsf(x))); }
__device__ __forceinline__ float wave_scan_sum(float v, int lane) {
#pragma unroll
    for (int o = 1; o < 64; o <<= 1) { const float t = __shfl_up(v, o); if (lane >= o) v += t; } return v; }
__device__ __forceinline__ float wave_scan_max(float v, int lane) {
#pragma unroll
    for (int o = 1; o < 64; o <<= 1) { const float t = __shfl_up(v, o); if (lane >= o) v = fmaxf(v, t); } return v; }
__device__ __forceinline__ float wave_max(float v) {
#pragma unroll
    for (int o = 32; o; o >>= 1) v = fmaxf(v, __shfl_xor(v, o)); return v; }
__device__ __forceinline__ float wave_sum(float v) {
#pragma unroll
    for (int o = 32; o; o >>= 1) v += __shfl_xor(v, o); return v; }
template <int NK32> __device__ __forceinline__ f32x4 mma_k(lptr X, int ldx, lptr Y, int ldy, int fr, int fq, f32x4 acc) {
    lptr xp = X + fr * ldx + fq * 16; lptr yp = Y + fr * ldy + fq * 16;
#pragma unroll
    for (int k = 0; k < NK32; ++k) { const bf16x8 x = *(const PG8_LAS bf16x8*)(xp + k * 64); const bf16x8 y = *(const PG8_LAS bf16x8*)(yp + k * 64); acc = __builtin_amdgcn_mfma_f32_16x16x32_bf16(x, y, acc, 0, 0, 0); }
    return acc; }
__device__ __forceinline__ void st_tr8(lptr T, int pitch, int r0, int cbyte, u32x4 v) {
    *(PG8_LAS bf16_t*)(T + (r0 + 0) * pitch + cbyte) = (bf16_t)(v.x & 0xffff); *(PG8_LAS bf16_t*)(T + (r0 + 1) * pitch + cbyte) = (bf16_t)(v.x >> 16);
    *(PG8_LAS bf16_t*)(T + (r0 + 2) * pitch + cbyte) = (bf16_t)(v.y & 0xffff); *(PG8_LAS bf16_t*)(T + (r0 + 3) * pitch + cbyte) = (bf16_t)(v.y >> 16);
    *(PG8_LAS bf16_t*)(T + (r0 + 4) * pitch + cbyte) = (bf16_t)(v.z & 0xffff); *(PG8_LAS bf16_t*)(T + (r0 + 5) * pitch + cbyte) = (bf16_t)(v.z >> 16);
    *(PG8_LAS bf16_t*)(T + (r0 + 6) * pitch + cbyte) = (bf16_t)(v.w & 0xffff); *(PG8_LAS bf16_t*)(T + (r0 + 7) * pitch + cbyte) = (bf16_t)(v.w >> 16); }

__device__ __forceinline__ void phase_prologue(const Args& a, lptr lds) {
    const int tid = ltid();
    lfptr tile = (lfptr)lds;
    bf16_t* Win = (bf16_t*)(a.ws + WS_WIN); bf16_t* Wout = (bf16_t*)(a.ws + WS_WOUT);
    for (int it = blockIdx.x; it < 2304 + 512; it += gridDim.x) {
        const float* src; bf16_t* dst; int ld, so, nvalid, k0;
        if (it < 2304) { const int l = it / 1152, r = it % 1152, kt = r / 72, nt = r % 72, n0 = nt * 64; k0 = kt * 64;
            src = a.w_in + (size_t)l * 1024 * 4488; ld = 4488;
            if (n0 < 1920) { so = n0; nvalid = 64; } else if (n0 < 4480) { so = n0 + 8; nvalid = 64; } else if (n0 == 4480) { so = 1920; nvalid = 8; } else { so = 0; nvalid = 0; }
            dst = Win + ((size_t)l * NPAD + n0) * 1024 + k0;
        } else { const int r0 = it - 2304, l = r0 / 256, r = r0 % 256, kt = r / 16, nt = r % 16, n0 = nt * 64; k0 = kt * 64;
            src = a.w_out + (size_t)l * 1024 * 1024; ld = 1024; so = n0; nvalid = 64; dst = Wout + ((size_t)l * 1024 + n0) * 1024 + k0; }
#pragma unroll
        for (int i = 0; i < 8; ++i) { const int kk = (tid >> 6) + 8 * i, nn = tid & 63; tile[kk * 65 + nn] = nn < nvalid ? src[(size_t)(k0 + kk) * ld + so + nn] : 0.f; }
        __syncthreads();
        { const int nn = tid >> 3, kk0 = (tid & 7) * 8; float v[8];
#pragma unroll
          for (int j = 0; j < 8; ++j) v[j] = tile[(kk0 + j) * 65 + nn];
          u32x4 w; w.x = cvt_pk(v[0], v[1]); w.y = cvt_pk(v[2], v[3]); w.z = cvt_pk(v[4], v[5]); w.w = cvt_pk(v[6], v[7]);
          *(u32x4*)(dst + (size_t)nn * 1024 + kk0) = w; }
        __syncthreads();
    }
    bf16_t* XM = (bf16_t*)(a.ws + WS_XM);
    const int gt = blockIdx.x * 512 + tid, gs = gridDim.x * 512;
    for (int i = gt; i < (NPR + NSM) * 128; i += gs) { const int row = i >> 7, c8 = (i & 127) * 8;
        const float* s = row < NPR ? a.x_prompt + (size_t)row * 1024 + c8 : a.x_sample + (size_t)(row - NPR) * 1024 + c8;
        const f32x4 v0 = *(const f32x4*)s, v1 = *(const f32x4*)(s + 4);
        u32x4 w; w.x = cvt_pk(v0[0], v0[1]); w.y = cvt_pk(v0[2], v0[3]); w.z = cvt_pk(v1[0], v1[1]); w.w = cvt_pk(v1[2], v1[3]);
        *(u32x4*)(XM + (size_t)row * 1024 + c8) = w; }
    float* rope = (float*)(a.ws + WS_ROPE);
    for (int i = gt; i < 2049 * 48; i += gs) { const int p = i / 48, j = i % 48; const float pos = p < 2048 ? (float)p : 16384.0f;
        const float inv = powf(10000.0f, -(float)j / 48.0f); const float ang = pos * inv;
        const double x = (double)ang; const double n = rint(x * 0.15915494309189535); const float r = (float)(x - n * 6.283185307179586);
        rope[2 * i] = cosf(r); rope[2 * i + 1] = sinf(r); }
}

struct EpiProj {
    static constexpr bool PERM = true, AFTER_DRAIN = false;
    bf16_t* proj; float* gates;
    __device__ __forceinline__ void operator()(const f32x4 (&acc)[2][2][4][2], const pg8::Unit& u, int wr, int wc, int fr, int fq) const {
        const int row0 = u.pm * 256 + wr * 64 + fr, colb = u.pn * 256 + wc * 32 + 8 * fq;
#pragma unroll
        for (int ai = 0; ai < 2; ++ai)
#pragma unroll
            for (int m = 0; m < 4; ++m) { const int row = row0 + ai * 128 + m * 16;
#pragma unroll
                for (int bj = 0; bj < 2; ++bj) { const int c0 = colb + bj * 128; const f32x4 v0 = acc[ai][bj][m][0], v1 = acc[ai][bj][m][1];
                    if (c0 < NPROJ) { u32x4 w; w.x = cvt_pk(v0[0], v0[1]); w.y = cvt_pk(v0[2], v0[3]); w.z = cvt_pk(v1[0], v1[1]); w.w = cvt_pk(v1[2], v1[3]);
                        *(u32x4*)(proj + (size_t)row * NPROJ + c0) = w; }
                    else if (c0 == NPROJ) { *(f32x4*)(gates + (size_t)row * 8) = v0; *(f32x4*)(gates + (size_t)row * 8 + 4) = v1; } } }
    }
};
struct EpiOut {
    static constexpr bool PERM = false, AFTER_DRAIN = false;
    const float* xres; float* pre;
    __device__ __forceinline__ void operator()(const f32x4 (&acc)[2][2][4][2], const pg8::Unit& u, int wr, int wc, int fr, int fq) const {
        const int row0 = u.pm * 256 + wr * 64 + fr, col0 = u.pn * 256 + wc * 32 + 4 * fq;
#pragma unroll
        for (int ai = 0; ai < 2; ++ai)
#pragma unroll
            for (int m = 0; m < 4; ++m) { const size_t off = (size_t)(row0 + ai * 128 + m * 16) * 1024 + col0;
#pragma unroll
                for (int bj = 0; bj < 2; ++bj)
#pragma unroll
                    for (int n = 0; n < 2; ++n) { const f32x4 xr = *(const f32x4*)(xres + off + bj * 128 + n * 16); *(f32x4*)(pre + off + bj * 128 + n * 16) = xr * ALPHA + acc[ai][bj][m][n]; } }
    }
};

__device__ __forceinline__ void phase_ln(const Args& a, int layer) {
    const int tid = ltid(), wid = tid >> 6, lane = tid & 63;
    const float* pre = (const float*)(a.ws + WS_PROJ); const float* g = a.ln_g + layer * 1024; const float* bb = a.ln_b + layer * 1024;
    bf16_t* XM = (bf16_t*)(a.ws + WS_XM);
    for (int row = blockIdx.x * 8 + wid; row < NPR + NSM; row += gridDim.x * 8) {
        const float* src = row < NPR ? pre + (size_t)row * 1024 : (const float*)(a.ws + WS_PRES) + (size_t)(row - NPR) * 1024;
        float* dst = row < NPR ? a.out + O_Y + (size_t)row * 1024 : a.out + O_YS + (size_t)(row - NPR) * 1024;
        f32x4 v[4]; float s = 0.f;
#pragma unroll
        for (int i = 0; i < 4; ++i) { v[i] = *(const f32x4*)(src + i * 256 + lane * 4); s += (v[i][0] + v[i][1]) + (v[i][2] + v[i][3]); }
        const float mu = wave_sum(s) * (1.0f / 1024.0f); float q = 0.f;
#pragma unroll
        for (int i = 0; i < 4; ++i) { const f32x4 d = v[i] - mu; q += (d[0] * d[0] + d[1] * d[1]) + (d[2] * d[2] + d[3] * d[3]); }
        const float rstd = rsqrtf(wave_sum(q) * (1.0f / 1024.0f) + 1e-5f);
#pragma unroll
        for (int i = 0; i < 4; ++i) { const int c = i * 256 + lane * 4; const f32x4 gg = *(const f32x4*)(g + c), b4 = *(const f32x4*)(bb + c); const f32x4 y = (v[i] - mu) * rstd * gg + b4;
            *(f32x4*)(dst + c) = y;
            if (layer == 0) { u32x2 w; w.x = cvt_pk(y[0], y[1]); w.y = cvt_pk(y[2], y[3]); *(u32x2*)(XM + (size_t)row * 1024 + c) = w; } }
    }
}

__device__ __forceinline__ float ret_lg(int h) { return log1pf(-exp2f(-5.0f - (float)h)); }

template <int MIX> __device__ __forceinline__ void m1_qkv(const Args& a, int layer, int it, lptr lds) {
    const int tid = ltid(), wid = tid >> 6, lane = tid & 63, fr = lane & 15, fq = lane >> 4;
    const int bh = it >> 5, c = it & 31, b = bh >> 2, h = bh & 3, row0 = b * 2048 + c * 64;
    const bf16_t* proj = (const bf16_t*)(a.ws + WS_PROJ);
    lptr KT = lds, VT = lds + 13824, RAW = lds + 27648; lfptr WV = (lfptr)(lds + 40512);
    const int kcol = (MIX == 0 ? C_MK : C_RK) + 96 * h, vcol = (MIX == 0 ? C_MV : C_RV) + 96 * h;
    constexpr int R0 = (MIX == 0) ? 3 : 0;
    for (int i = tid; i < (64 + R0) * 12; i += 512) { const int rr = i / 12, c8 = (i % 12) * 8, t = c * 64 - R0 + rr; u32x4 v = (u32x4){0u, 0u, 0u, 0u};
        if (t >= 0) v = *(const u32x4*)(proj + (size_t)(b * 2048 + t) * NPROJ + kcol + c8);
        *(PG8_LAS u32x4*)(RAW + rr * 192 + c8 * 2) = v; }
    for (int i = tid; i < 64 * 12; i += 512) { const int s = i / 12, c8 = (i % 12) * 8; const u32x4 v = *(const u32x4*)(proj + (size_t)(row0 + s) * NPROJ + vcol + c8); st_tr8(VT, 144, c8, s * 2, v); }
    float* sc = (float*)(a.ws + WS_SC);
    if (MIX == 0 && wid == 0) { const float* gt = (const float*)(a.ws + WS_GATES) + (size_t)(row0 + lane) * 8; const float* bm = a.b_mgate + layer * 8;
        const float ig = gt[h] + bm[h], lf = logsigmoidf_(gt[4 + h] + bm[4 + h]); const float bc = wave_scan_sum(lf, lane); const float G = __shfl(bc, 63);
        const float as = G - bc + ig; const float ml = wave_max(as); WV[lane] = __expf(as - ml);
        if (lane == 0) { sc[it * 4 + 0] = G; sc[it * 4 + 1] = ml; } }
    __syncthreads();
    if (MIX == 0) {
        if (tid < 480) { const int d = tid % 96, sg = tid / 96; const float* cw = a.conv_w + (size_t)layer * 4 * 768 + 384 + 96 * h + d;
            const float w0 = cw[0], w1 = cw[768], w2 = cw[1536], w3 = cw[2304], cb = a.conv_b[layer * 768 + 384 + 96 * h + d];
            for (int s = sg; s < 64; s += 5) {
                const float x0 = bf2f(*(PG8_LAS bf16_t*)(RAW + (s + 0) * 192 + d * 2)), x1 = bf2f(*(PG8_LAS bf16_t*)(RAW + (s + 1) * 192 + d * 2)),
                            x2 = bf2f(*(PG8_LAS bf16_t*)(RAW + (s + 2) * 192 + d * 2)), x3 = bf2f(*(PG8_LAS bf16_t*)(RAW + (s + 3) * 192 + d * 2));
                const float val = cb + w0 * x0 + w1 * x1 + w2 * x2 + w3 * x3;
                *(PG8_LAS bf16_t*)(KT + d * 144 + s * 2) = f2bf(siluf_(val) * WV[s] * DH_SCALE); } }
    } else {
        const float lg = ret_lg(h); const float* rope = (const float*)(a.ws + WS_ROPE);
        for (int i = tid; i < 64 * 48; i += 512) { const int s = i / 48, j = i % 48;
            const float x1 = bf2f(*(PG8_LAS bf16_t*)(RAW + s * 192 + j * 2)), x2 = bf2f(*(PG8_LAS bf16_t*)(RAW + s * 192 + (j + 48) * 2));
            const float cs = rope[((c * 64 + s) * 48 + j) * 2], sn = rope[((c * 64 + s) * 48 + j) * 2 + 1]; const float dec = __expf((float)(63 - s) * lg) * DH_SCALE;
            *(PG8_LAS bf16_t*)(KT + j * 144 + s * 2) = f2bf((x1 * cs - x2 * sn) * dec); *(PG8_LAS bf16_t*)(KT + (j + 48) * 144 + s * 2) = f2bf((x1 * sn + x2 * cs) * dec); }
    }
    __syncthreads();
    bf16_t* U = (bf16_t*)(a.ws + (MIX == 0 ? WS_UM : WS_UR)) + (size_t)it * 9216;
    for (int blk = wid; blk < 36; blk += 8) { const int vi = blk / 6, di = blk % 6;
        f32x4 acc = (f32x4){0.f, 0.f, 0.f, 0.f}; acc = mma_k<2>(KT + di * 16 * 144, 144, VT + vi * 16 * 144, 144, fr, fq, acc);
        u32x2 w; w.x = cvt_pk(acc[0], acc[1]); w.y = cvt_pk(acc[2], acc[3]); *(u32x2*)(U + (16 * vi + fr) * 96 + 16 * di + 4 * fq) = w; }
    if (MIX == 0 && tid < 96) { float s = 0.f;
#pragma unroll
        for (int k = 0; k < 8; ++k) { const u32x4 v = *(const PG8_LAS u32x4*)(KT + tid * 144 + k * 16); s += (bflo(v.x) + bfhi(v.x)) + (bflo(v.y) + bfhi(v.y)) + (bflo(v.z) + bfhi(v.z)) + (bflo(v.w) + bfhi(v.w)); }
        ((float*)(a.ws + WS_NU))[it * 96 + tid] = s; }
    __syncthreads();
}

__device__ __forceinline__ float hgrn_lb(const Args& a, int layer, int col) { return layer ? sigmoidf_(a.hgrn_lb[256 + col] - a.hgrn_lb[col]) : 0.f; }

__device__ __forceinline__ void m1_hgrn(const Args& a, int layer, int it, lptr lds) {
    const int tid = ltid(), wid = tid >> 6, lane = tid & 63, fr = lane & 15, fq = lane >> 4;
    const int bh = it >> 5, c = it & 31, b = bh >> 2, h = bh & 3, row0 = b * 2048 + c * 64;
    const bf16_t* proj = (const bf16_t*)(a.ws + WS_PROJ);
    lptr KT = lds, VT = lds + 9216; lfptr SEG = (lfptr)(lds + 18432);
    const int ch = tid & 63, seg = tid >> 6; const float lb = hgrn_lb(a, layer, 64 * h + ch);
    float kv[8], bc[8]; float run = 0.f;
#pragma unroll
    for (int i = 0; i < 8; ++i) { const float fp = bf2f(proj[(size_t)(row0 + seg * 8 + i) * NPROJ + C_HF + 64 * h + ch]); const float k = (1.0f - lb) / (1.0f + __expf(fp)); kv[i] = k; run += log1pf(-k); bc[i] = run; }
    SEG[seg * 64 + ch] = run;
    { const int s = tid >> 3, c8 = (tid & 7) * 8; const u32x4 v = *(const u32x4*)(proj + (size_t)(row0 + s) * NPROJ + C_HI + 64 * h + c8); st_tr8(VT, 144, c8, s * 2, v); }
    __syncthreads();
    float off = 0.f, tot = 0.f;
#pragma unroll
    for (int s2 = 0; s2 < 8; ++s2) { const float x = SEG[s2 * 64 + ch]; tot += x; if (s2 < seg) off += x; }
    { float o[8];
#pragma unroll
      for (int i = 0; i < 8; ++i) o[i] = kv[i] * __expf(tot - (off + bc[i]));
      u32x4 w; w.x = cvt_pk(o[0], o[1]); w.y = cvt_pk(o[2], o[3]); w.z = cvt_pk(o[4], o[5]); w.w = cvt_pk(o[6], o[7]); *(PG8_LAS u32x4*)(KT + ch * 144 + seg * 16) = w; }
    if (seg == 0) ((float*)(a.ws + WS_EG))[it * 64 + ch] = __expf(tot);
    __syncthreads();
    bf16_t* U = (bf16_t*)(a.ws + WS_UH) + (size_t)it * 4096;
    for (int blk = wid; blk < 16; blk += 8) { const int vi = blk >> 2, ci = blk & 3;
        f32x4 acc = (f32x4){0.f, 0.f, 0.f, 0.f}; acc = mma_k<2>(KT + ci * 16 * 144, 144, VT + vi * 16 * 144, 144, fr, fq, acc);
        u32x2 w; w.x = cvt_pk(acc[0], acc[1]); w.y = cvt_pk(acc[2], acc[3]); *(u32x2*)(U + (16 * vi + fr) * 64 + 16 * ci + 4 * fq) = w; }
    __syncthreads();
}

template <int K, int V> __device__ __forceinline__ void state_pass(const float* Min, float* Mout, lfptr qe, lfptr dk, lfptr kk, lfptr vv, lfptr numacc) {
    constexpr int V4 = V / 4, KG = 512 / V4; const int tid = ltid();
    if (tid < V4 * KG) { const int v4 = tid % V4, kg = tid / V4; f32x4 acc = (f32x4){0.f, 0.f, 0.f, 0.f}; const f32x4 vvv = *(const PG8_LAS f32x4*)(vv + 4 * v4);
        for (int k = kg; k < K; k += KG) { const f32x4 m = *(const f32x4*)(Min + k * V + 4 * v4); acc += m * qe[k]; *(f32x4*)(Mout + k * V + 4 * v4) = m * dk[k] + vvv * kk[k]; }
#pragma unroll
        for (int j = 0; j < 4; ++j) atomicAdd((float*)(numacc + 4 * v4 + j), acc[j]); }
}

__device__ __forceinline__ void sample_item(const Args& a, int layer, int idx, lptr lds) {
    const int tid = ltid(), lane = tid & 63;
    const int mix = idx / 512, b = (idx % 512) >> 2, h = idx & 3, row = NPR + b;
    const bf16_t* prow = (const bf16_t*)(a.ws + WS_PROJ) + (size_t)row * NPROJ; bf16_t* xm = (bf16_t*)(a.ws + WS_XM) + (size_t)row * 1024;
    lfptr qv = (lfptr)lds, kv = qv + 96, vv = kv + 96, dk = vv + 96, qe = dk + 96, numacc = qe + 96, hv = numacc + 96;
    if (mix == 0) {
        if (tid < 192) { const int col = tid < 96 ? 96 * h + tid : 384 + 96 * h + (tid - 96); const float cur = bf2f(prow[col]);
            const float* bufp = a.st_conv + ((size_t)(layer * 128 + b) * 3) * 768 + col; const float b0 = bufp[0], b1 = bufp[768], b2 = bufp[1536];
            const float* cw = a.conv_w + (size_t)layer * 4 * 768 + col; float val = a.conv_b[layer * 768 + col] + cw[0] * b0 + cw[768] * b1 + cw[1536] * b2 + cw[2304] * cur; val = siluf_(val);
            if (tid < 96) qv[tid] = val; else kv[tid - 96] = val * DH_SCALE;
            float* co = a.out + O_CONV_S + ((size_t)(layer * 128 + b) * 3) * 768 + col; co[0] = b1; co[768] = b2; co[1536] = cur; }
        else if (tid < 288) vv[tid - 192] = bf2f(prow[C_MV + 96 * h + tid - 192]);
        else if (tid < 384) numacc[tid - 288] = 0.f;
        __syncthreads();
        const float* gt = (const float*)(a.ws + WS_GATES) + (size_t)row * 8; const float* bm = a.b_mgate + layer * 8;
        const float ig = gt[h] + bm[h], lf = logsigmoidf_(gt[4 + h] + bm[4 + h]); const size_t sbh = (size_t)(layer * 128 + b) * 4 + h; const float mp = a.st_m[sbh];
        const float mt = fmaxf(ig, lf + mp), sfac = __expf(ig - mt), wpr = __expf(lf + mp - mt);
        const float* nin = a.st_n + sbh * 96;
        float pqk = qv[lane] * kv[lane], pqn = qv[lane] * nin[lane]; if (lane < 32) { pqk += qv[lane + 64] * kv[lane + 64]; pqn += qv[lane + 64] * nin[lane + 64]; }
        const float qk = wave_sum(pqk), qn = wave_sum(pqn);
        if (tid < 96) { dk[tid] = wpr; qe[tid] = qv[tid]; }
        __syncthreads();
        if (tid < 96) kv[tid] = kv[tid] * sfac;
        __syncthreads();
        state_pass<96, 96>(a.st_C + sbh * 9216, a.out + O_MC_S + sbh * 9216, qe, dk, kv, vv, numacc);
        __syncthreads();
        if (tid < 96) { const float s = qk * sfac; const float num = s * vv[tid] + wpr * numacc[tid]; const float den = s + wpr * qn; hv[tid] = num / fmaxf(fabsf(den), __expf(-mt));
            a.out[O_MN_S + sbh * 96 + tid] = wpr * nin[tid] + kv[tid]; if (tid == 0) a.out[O_MM_S + sbh] = mt; }
        __syncthreads();
        if (tid < 96) { float mu = 0.f; for (int i = 0; i < 96; ++i) mu += hv[i]; mu *= (1.0f / 96.0f); float q = 0.f; for (int i = 0; i < 96; ++i) { const float d = hv[i] - mu; q += d * d; }
            const float rstd = rsqrtf(q * (1.0f / 96.0f) + 1e-6f); const int col = 96 * h + tid;
            const float y = (hv[tid] - mu) * rstd * a.m_norm_w[layer * 384 + col] * sigmoidf_(bf2f(prow[C_MO + col])) * siluf_(bf2f(prow[C_MZ + col])); xm[col] = f2bf(y); }
    } else if (mix == 1) {
        const float lg = ret_lg(h), gam = __expf(lg); const float* rope = (const float*)(a.ws + WS_ROPE) + (size_t)2048 * 96;
        if (tid < 96) { const int which = tid / 48, j = tid % 48; const int base = (which == 0 ? C_RQ : C_RK) + 96 * h; const float x1 = bf2f(prow[base + j]), x2 = bf2f(prow[base + j + 48]);
            const float cs = rope[2 * j], sn = rope[2 * j + 1]; const float o1 = x1 * cs - x2 * sn, o2 = x1 * sn + x2 * cs;
            if (which == 0) { qv[j] = o1; qv[j + 48] = o2; } else { kv[j] = o1 * DH_SCALE; kv[j + 48] = o2 * DH_SCALE; } }
        else if (tid < 192) vv[tid - 96] = bf2f(prow[C_RV + 96 * h + tid - 96]);
        else if (tid < 288) { numacc[tid - 192] = 0.f; dk[tid - 192] = gam; }
        __syncthreads();
        float pqk = qv[lane] * kv[lane]; if (lane < 32) pqk += qv[lane + 64] * kv[lane + 64]; const float qk = wave_sum(pqk);
        const size_t sbh = (size_t)(layer * 128 + b) * 4 + h;
        state_pass<96, 96>(a.st_ret + sbh * 9216, a.out + O_RET_S + sbh * 9216, qv, dk, kv, vv, numacc);
        __syncthreads();
        if (tid < 96) hv[tid] = qk * vv[tid] + gam * numacc[tid];
        __syncthreads();
        if (tid < 96) { float mu = 0.f; for (int i = 0; i < 96; ++i) mu += hv[i]; mu *= (1.0f / 96.0f); float q = 0.f; for (int i = 0; i < 96; ++i) { const float d = hv[i] - mu; q += d * d; }
            const float rstd = rsqrtf(q * (1.0f / 96.0f) + 1e-6f); const int col = 96 * h + tid;
            const float y = (hv[tid] - mu) * rstd * a.r_norm_w[layer * 384 + col] * siluf_(bf2f(prow[C_RG + col])); xm[384 + col] = f2bf(y); }
    } else {
        if (tid < 64) { const int col = 64 * h + tid; const float lb = hgrn_lb(a, layer, col); const float fp = bf2f(prow[C_HF + col]); const float k = (1.0f - lb) / (1.0f + __expf(fp)); const float f = 1.0f - k;
            const float q = bf2f(prow[C_HQ + col]); qv[tid] = q; kv[tid] = k; dk[tid] = f; qe[tid] = q * f; vv[tid] = bf2f(prow[C_HI + col]); numacc[tid] = 0.f; }
        __syncthreads();
        const float qk = wave_sum(qv[lane] * kv[lane]);
        const size_t sbh = (size_t)(layer * 128 + b) * 4 + h;
        state_pass<64, 64>(a.st_hgrn + sbh * 4096, a.out + O_HG_S + sbh * 4096, qe, dk, kv, vv, numacc);
        __syncthreads();
        if (tid < 64) hv[tid] = qk * vv[tid] + numacc[tid];
        __syncthreads();
        if (tid < 64) { float q = 0.f; for (int i = 0; i < 64; ++i) q += hv[i] * hv[i]; const float rstd = rsqrtf(q * (1.0f / 64.0f) + 1e-6f); const int col = 64 * h + tid;
            const float y = hv[tid] * rstd * a.h_norm_w[layer * 256 + col] * siluf_(bf2f(prow[C_HG + col])); xm[768 + col] = f2bf(y); }
    }
    __syncthreads();
}

__device__ __forceinline__ void phase_m1(const Args& a, int layer, lptr lds) {
    for (int idx = blockIdx.x; idx < 3072 + 1536; idx += gridDim.x) {
        if (idx < 1024) m1_qkv<0>(a, layer, idx, lds);
        else if (idx < 2048) m1_qkv<1>(a, layer, idx - 1024, lds);
        else if (idx < 3072) m1_hgrn(a, layer, idx - 2048, lds);
        else sample_item(a, layer, idx - 3072, lds);
    }
}

__device__ __forceinline__ void ld8(const bf16_t* p, float (&u)[8]) { const u32x4 v = *(const u32x4*)p; u[0] = bflo(v.x); u[1] = bfhi(v.x); u[2] = bflo(v.y); u[3] = bfhi(v.y); u[4] = bflo(v.z); u[5] = bfhi(v.z); u[6] = bflo(v.w); u[7] = bfhi(v.w); }
__device__ __forceinline__ void st8(bf16_t* p, const float (&u)[8]) { u32x4 w; w.x = cvt_pk(u[0], u[1]); w.y = cvt_pk(u[2], u[3]); w.z = cvt_pk(u[4], u[5]); w.w = cvt_pk(u[6], u[7]); *(u32x4*)p = w; }

__device__ __forceinline__ void sample_out(const Args& a, int layer, int item, lptr lds) {
    const int tid = ltid(), wid = tid >> 6, lane = tid & 63, fr = lane & 15, fq = lane >> 4;
    const int ri = item >> 3, ci = item & 7;
    lptr AS = lds;
    const bf16_t* XM = (const bf16_t*)(a.ws + WS_XM) + (size_t)(NPR + 16 * ri) * 1024;
    const bf16_t* W = (const bf16_t*)(a.ws + WS_WOUT) + (size_t)layer * 1024 * 1024;
    for (int i = tid; i < 16 * 128; i += 512) { const int r = i >> 7, c8 = (i & 127) * 8; *(PG8_LAS u32x4*)(AS + r * 2064 + c8 * 2) = *(const u32x4*)(XM + (size_t)r * 1024 + c8); }
    const int nb = ci * 8 + wid;
    const bf16_t* wp = W + (size_t)(nb * 16 + fr) * 1024 + fq * 8;
    bf16x8 wreg[32];
#pragma unroll
    for (int k = 0; k < 32; ++k) wreg[k] = *(const bf16x8*)(wp + k * 32);
    __syncthreads();
    const float* xres = (layer == 0 ? a.x_sample : a.out + O_YS) + (size_t)(16 * ri) * 1024;
    f32x4 acc = (f32x4){0.f, 0.f, 0.f, 0.f}; lptr ap = AS + fr * 2064 + fq * 16;
#pragma unroll
    for (int k = 0; k < 32; ++k) { const bf16x8 y = *(const PG8_LAS bf16x8*)(ap + k * 64); acc = __builtin_amdgcn_mfma_f32_16x16x32_bf16(wreg[k], y, acc, 0, 0, 0); }
    const int n0 = nb * 16 + 4 * fq; const f32x4 xr = *(const f32x4*)(xres + (size_t)fr * 1024 + n0);
    *(f32x4*)((float*)(a.ws + WS_PRES) + (size_t)(16 * ri + fr) * 1024 + n0) = xr * ALPHA + acc;
    __syncthreads();
}

__device__ __forceinline__ void phase_m2(const Args& a, int layer, lptr lds) {
    const int tid = ltid(); float* sc = (float*)(a.ws + WS_SC);
    for (int task = blockIdx.x * 512 + tid; task < 93184; task += gridDim.x * 512) {
        if (task < 73728) {
            const bool isr = task >= 36864; const int t2 = isr ? task - 36864 : task; const int bh = t2 / 1152, e8 = t2 % 1152;
            bf16_t* base = (bf16_t*)(a.ws + (isr ? WS_UR : WS_UM)) + (size_t)bh * 32 * 9216 + e8 * 8;
            float C[8] = {0.f, 0.f, 0.f, 0.f, 0.f, 0.f, 0.f, 0.f}; float m = 0.f; const float g64 = __expf(64.0f * ret_lg(bh & 3));
            for (int cb = 0; cb < 32; cb += 8) { u32x4 ur[8];
#pragma unroll
                for (int q = 0; q < 8; ++q) ur[q] = *(const u32x4*)(base + (size_t)(cb + q) * 9216);
#pragma unroll
                for (int q = 0; q < 8; ++q) { const int c = cb + q; float dC, sU;
                    if (isr) { dC = g64; sU = 1.0f; } else { const float G = sc[(bh * 32 + c) * 4], ml = sc[(bh * 32 + c) * 4 + 1]; const float mn = fmaxf(G + m, ml); dC = __expf(G + m - mn); sU = __expf(ml - mn); m = mn; }
                    st8(base + (size_t)c * 9216, C);
                    const float u[8] = {bflo(ur[q].x), bfhi(ur[q].x), bflo(ur[q].y), bfhi(ur[q].y), bflo(ur[q].z), bfhi(ur[q].z), bflo(ur[q].w), bfhi(ur[q].w)};
#pragma unroll
                    for (int j = 0; j < 8; ++j) C[j] = dC * C[j] + sU * u[j]; } }
            const int v = e8 / 12, d0 = (e8 % 12) * 8; float* o = a.out + (isr ? O_RET_P : O_MC_P) + ((size_t)layer * 32 + bh) * 9216;
#pragma unroll
            for (int j = 0; j < 8; ++j) o[(d0 + j) * 96 + v] = C[j];
        } else if (task < 90112) {
            const int t2 = task - 73728, bh = t2 / 512, e8 = t2 % 512; bf16_t* base = (bf16_t*)(a.ws + WS_UH) + (size_t)bh * 32 * 4096 + e8 * 8;
            const int v = e8 / 8, c0 = (e8 % 8) * 8; const float* eg = (const float*)(a.ws + WS_EG) + (size_t)bh * 32 * 64 + c0;
            float S[8] = {0.f, 0.f, 0.f, 0.f, 0.f, 0.f, 0.f, 0.f};
            for (int cb = 0; cb < 32; cb += 8) { u32x4 ur[8];
#pragma unroll
                for (int q = 0; q < 8; ++q) ur[q] = *(const u32x4*)(base + (size_t)(cb + q) * 4096);
#pragma unroll
                for (int q = 0; q < 8; ++q) { const int c = cb + q; const f32x4 e0 = *(const f32x4*)(eg + c * 64), e1 = *(const f32x4*)(eg + c * 64 + 4);
                    st8(base + (size_t)c * 4096, S);
                    const float u[8] = {bflo(ur[q].x), bfhi(ur[q].x), bflo(ur[q].y), bfhi(ur[q].y), bflo(ur[q].z), bfhi(ur[q].z), bflo(ur[q].w), bfhi(ur[q].w)};
#pragma unroll
                    for (int j = 0; j < 4; ++j) { S[j] = e0[j] * S[j] + u[j]; S[j + 4] = e1[j] * S[j + 4] + u[j + 4]; } } }
            float* o = a.out + O_HG_P + ((size_t)layer * 32 + bh) * 4096;
#pragma unroll
            for (int j = 0; j < 8; ++j) o[(c0 + j) * 64 + v] = S[j];
        } else {
            const int t3 = task - 90112, bh = t3 / 96, d = t3 % 96; float* nu = (float*)(a.ws + WS_NU) + (size_t)bh * 32 * 96 + d; float n = 0.f, m = 0.f;
            for (int c = 0; c < 32; ++c) { const float G = sc[(bh * 32 + c) * 4], ml = sc[(bh * 32 + c) * 4 + 1]; const float u = nu[c * 96]; const float mn = fmaxf(G + m, ml);
                nu[c * 96] = n; if (d == 0) sc[(bh * 32 + c) * 4 + 2] = m; n = __expf(G + m - mn) * n + __expf(ml - mn) * u; m = mn; }
            a.out[O_MN_P + ((size_t)layer * 32 + bh) * 96 + d] = n; if (d == 0) a.out[O_MM_P + layer * 32 + bh] = m;
        }
    }
    const int wb = (int)gridDim.x - 1 - (int)blockIdx.x;
    for (int item = wb; item < 64; item += gridDim.x) sample_out(a, layer, item, lds);
}

template <int MIX> __device__ __forceinline__ void m3_qkv(const Args& a, int layer, int it, lptr lds) {
    const int tid = ltid(), wid = tid >> 6, lane = tid & 63, fr = lane & 15, fq = lane >> 4;
    const int bh = it >> 5, c = it & 31, b = bh >> 2, h = bh & 3, row0 = b * 2048 + c * 64;
    const bf16_t* proj = (const bf16_t*)(a.ws + WS_PROJ);
    lptr QS = lds, KS = lds + 13312, VT = lds + 26624, CT = lds + 40448, PS = lds + 60416, RAW = lds + 95232;
    lfptr HS = (lfptr)(lds + 69632); lfptr SC = (lfptr)(lds + 120960);
    lfptr rowterm = SC, gs = SC + 64, wprior = SC + 128, enm = SC + 192, rowsum = SC + 256, qn = SC + 320, nvec = SC + 384;
    constexpr int R0 = (MIX == 0) ? 3 : 0;
    const int qcol = (MIX == 0 ? C_MQ : C_RQ) + 96 * h, kcol = (MIX == 0 ? C_MK : C_RK) + 96 * h, vcol = (MIX == 0 ? C_MV : C_RV) + 96 * h;
    const float lg = ret_lg(h);
    for (int i = tid; i < (64 + R0) * 24; i += 512) { const int rr = i / 24, c8 = (i % 24) * 8, t = c * 64 - R0 + rr; u32x4 v = (u32x4){0u, 0u, 0u, 0u};
        if (t >= 0) v = *(const u32x4*)(proj + (size_t)(b * 2048 + t) * NPROJ + (c8 < 96 ? qcol + c8 : kcol + c8 - 96));
        *(PG8_LAS u32x4*)(RAW + rr * 384 + c8 * 2) = v; }
    for (int i = tid; i < 64 * 12; i += 512) { const int s = i / 12, c8 = (i % 12) * 8; const u32x4 v = *(const u32x4*)(proj + (size_t)(row0 + s) * NPROJ + vcol + c8); st_tr8(VT, 144, c8, s * 2, v); }
    { const bf16_t* U = (const bf16_t*)(a.ws + (MIX == 0 ? WS_UM : WS_UR)) + (size_t)it * 9216;
      for (int i = tid; i < 1152; i += 512) { const int v = i / 12, c8 = (i % 12) * 8; *(PG8_LAS u32x4*)(CT + v * 208 + c8 * 2) = *(const u32x4*)(U + v * 96 + c8); } }
    if (MIX == 0) {
        if (tid >= 64 && tid < 160) nvec[tid - 64] = ((const float*)(a.ws + WS_NU))[it * 96 + tid - 64];
        if (wid == 0) { const float* gt = (const float*)(a.ws + WS_GATES) + (size_t)(row0 + lane) * 8; const float* bm = a.b_mgate + layer * 8;
            const float ig = gt[h] + bm[h], lf = logsigmoidf_(gt[4 + h] + bm[4 + h]); const float bc = wave_scan_sum(lf, lane); const float g = ig - bc; const float pm = wave_scan_max(g, lane);
            const float mc = ((const float*)(a.ws + WS_SC))[it * 4 + 2]; const float M = fmaxf(pm, mc);
            rowterm[lane] = -M; gs[lane] = g; wprior[lane] = __expf(mc - M); enm[lane] = __expf(-(bc + M)); rowsum[lane] = 0.f; }
    }
    __syncthreads();
    if (MIX == 0) {
#pragma unroll
        for (int ci = 0; ci < 3; ++ci) { const int col = lane + 64 * ci; const int gcol = col < 96 ? 96 * h + col : 384 + 96 * h + col - 96;
            const float* cw = a.conv_w + (size_t)layer * 4 * 768 + gcol; const float w0 = cw[0], w1 = cw[768], w2 = cw[1536], w3 = cw[2304], cb = a.conv_b[layer * 768 + gcol];
            const float scl = col < 96 ? 1.0f : DH_SCALE; lptr dst = col < 96 ? QS + col * 2 : KS + (col - 96) * 2;
            float x0 = bf2f(*(PG8_LAS bf16_t*)(RAW + (8 * wid + 0) * 384 + col * 2)), x1 = bf2f(*(PG8_LAS bf16_t*)(RAW + (8 * wid + 1) * 384 + col * 2)), x2 = bf2f(*(PG8_LAS bf16_t*)(RAW + (8 * wid + 2) * 384 + col * 2));
#pragma unroll
            for (int i = 0; i < 8; ++i) { const int t = 8 * wid + i; const float x3 = bf2f(*(PG8_LAS bf16_t*)(RAW + (t + 3) * 384 + col * 2));
                const float val = cb + w0 * x0 + w1 * x1 + w2 * x2 + w3 * x3; *(PG8_LAS bf16_t*)(dst + t * 208) = f2bf(siluf_(val) * scl); x0 = x1; x1 = x2; x2 = x3; } }
        if (c == 31 && tid < 192) { const int gcol = tid < 96 ? 96 * h + tid : 384 + 96 * h + tid - 96; float* co = a.out + O_CONV_P + ((size_t)(layer * 8 + b) * 3) * 768 + gcol;
#pragma unroll
            for (int j = 0; j < 3; ++j) co[j * 768] = bf2f(*(PG8_LAS bf16_t*)(RAW + (64 + j) * 384 + tid * 2)); }
    } else {
        const float* rope = (const float*)(a.ws + WS_ROPE);
        for (int i = tid; i < 64 * 96; i += 512) { const int s = i / 96, jj = i % 96, which = jj / 48, j = jj % 48;
            const float x1 = bf2f(*(PG8_LAS bf16_t*)(RAW + s * 384 + (which * 96 + j) * 2)), x2 = bf2f(*(PG8_LAS bf16_t*)(RAW + s * 384 + (which * 96 + j + 48) * 2));
            const float cs = rope[((c * 64 + s) * 48 + j) * 2], sn = rope[((c * 64 + s) * 48 + j) * 2 + 1]; const float scl = which ? DH_SCALE : 1.0f; lptr dst = (which ? KS : QS) + s * 208;
            *(PG8_LAS bf16_t*)(dst + j * 2) = f2bf((x1 * cs - x2 * sn) * scl); *(PG8_LAS bf16_t*)(dst + (j + 48) * 2) = f2bf((x1 * sn + x2 * cs) * scl); }
    }
    __syncthreads();
    if (MIX == 0) { const int t = tid >> 3, part = tid & 7; float s = 0.f;
#pragma unroll
        for (int i = 0; i < 12; ++i) s += bf2f(*(PG8_LAS bf16_t*)(QS + t * 208 + (part * 12 + i) * 2)) * nvec[part * 12 + i];
        s += __shfl_xor(s, 1); s += __shfl_xor(s, 2); s += __shfl_xor(s, 4); if (part == 0) qn[t] = s; }
    { const int ti = wid >> 1;
#pragma unroll
      for (int sj = 0; sj < 2; ++sj) { const int si = 2 * (wid & 1) + sj; const int t = 16 * ti + fr, s0 = 16 * si + 4 * fq; u32x2 w = (u32x2){0u, 0u};
          if (si <= ti) { f32x4 acc = (f32x4){0.f, 0.f, 0.f, 0.f}; acc = mma_k<3>(KS + si * 16 * 208, 208, QS + ti * 16 * 208, 208, fr, fq, acc);
              float p[4];
#pragma unroll
              for (int j = 0; j < 4; ++j) { const int s = s0 + j; float dl; if (MIX == 0) dl = __expf(rowterm[t] + gs[s]); else dl = __expf((float)(t - s) * lg); p[j] = s <= t ? acc[j] * dl : 0.f; }
              if (MIX == 0) { float ps = (p[0] + p[1]) + (p[2] + p[3]); ps += __shfl_xor(ps, 16); ps += __shfl_xor(ps, 32); if (fq == 0) atomicAdd((float*)(rowsum + t), ps); }
              w.x = cvt_pk(p[0], p[1]); w.y = cvt_pk(p[2], p[3]); }
          *(PG8_LAS u32x2*)(PS + t * 144 + s0 * 2) = w; } }
    __syncthreads();
    { const int ti = wid >> 1; const int t = 16 * ti + fr;
#pragma unroll
      for (int vj = 0; vj < 3; ++vj) { const int vi = 3 * (wid & 1) + vj;
          f32x4 a1 = (f32x4){0.f, 0.f, 0.f, 0.f}, a2 = (f32x4){0.f, 0.f, 0.f, 0.f};
          a1 = mma_k<2>(VT + vi * 16 * 144, 144, PS + ti * 16 * 144, 144, fr, fq, a1);
          a2 = mma_k<3>(CT + vi * 16 * 208, 208, QS + ti * 16 * 208, 208, fr, fq, a2);
          f32x4 hq;
          if (MIX == 0) { const float wp = wprior[t]; const float den = rowsum[t] + qn[t] * wp; const float inv = 1.0f / fmaxf(fabsf(den), enm[t]); hq = (a1 + a2 * wp) * inv; }
          else { const float wp = __expf((float)(t + 1) * lg); hq = a1 + a2 * wp; }
          *(PG8_LAS f32x4*)(HS + t * 100 + 16 * vi + 4 * fq) = hq; } }
    __syncthreads();
    { const int t = tid >> 3, part = tid & 7; float hv[12]; float s = 0.f;
#pragma unroll
      for (int i = 0; i < 3; ++i) { const f32x4 x = *(const PG8_LAS f32x4*)(HS + t * 100 + part * 12 + 4 * i); hv[4 * i] = x[0]; hv[4 * i + 1] = x[1]; hv[4 * i + 2] = x[2]; hv[4 * i + 3] = x[3]; s += (x[0] + x[1]) + (x[2] + x[3]); }
      s += __shfl_xor(s, 1); s += __shfl_xor(s, 2); s += __shfl_xor(s, 4); const float mu = s * (1.0f / 96.0f); float q = 0.f;
#pragma unroll
      for (int i = 0; i < 12; ++i) { const float d = hv[i] - mu; q += d * d; }
      q += __shfl_xor(q, 1); q += __shfl_xor(q, 2); q += __shfl_xor(q, 4); const float rstd = rsqrtf(q * (1.0f / 96.0f) + 1e-6f);
      const int hc = 96 * h + part * 12; const bf16_t* pr = proj + (size_t)(row0 + t) * NPROJ; const float* nw = (MIX == 0 ? a.m_norm_w : a.r_norm_w) + layer * 384 + hc;
      bf16_t* mx = (bf16_t*)(a.ws + WS_XM) + (size_t)(row0 + t) * 1024 + (MIX == 0 ? 0 : 384) + hc;
#pragma unroll
      for (int i = 0; i < 3; ++i) { float y[4]; const u32x2 g1 = *(const u32x2*)(pr + (MIX == 0 ? C_MO : C_RG) + hc + 4 * i); float gg[4] = {bflo(g1.x), bfhi(g1.x), bflo(g1.y), bfhi(g1.y)};
          float zz[4] = {0.f, 0.f, 0.f, 0.f}; if (MIX == 0) { const u32x2 z1 = *(const u32x2*)(pr + C_MZ + hc + 4 * i); zz[0] = bflo(z1.x); zz[1] = bfhi(z1.x); zz[2] = bflo(z1.y); zz[3] = bfhi(z1.y); }
#pragma unroll
          for (int j = 0; j < 4; ++j) { const float gate = MIX == 0 ? sigmoidf_(gg[j]) * siluf_(zz[j]) : siluf_(gg[j]); y[j] = (hv[4 * i + j] - mu) * rstd * nw[4 * i + j] * gate; }
          u32x2 w; w.x = cvt_pk(y[0], y[1]); w.y = cvt_pk(y[2], y[3]); *(u32x2*)(mx + 4 * i) = w; } }
    __syncthreads();
}

__device__ __forceinline__ void m3_hgrn(const Args& a, int layer, int it, lptr lds) {
    const int tid = ltid(), wid = tid >> 6, lane = tid & 63, fr = lane & 15, fq = lane >> 4;
    const int bh = it >> 5, c = it & 31, b = bh >> 2, h = bh & 3, row0 = b * 2048 + c * 64;
    const bf16_t* proj = (const bf16_t*)(a.ws + WS_PROJ);
    lfptr BC = (lfptr)lds;
    lptr QH = lds + 16640, QT = lds + 25856, KI = lds + 35072  , VT = lds + 71936, ST = lds + 81152, PS = lds + 90368; lfptr HS = (lfptr)(lds + 99584); lfptr SEG = (lfptr)(lds + 116992);
    const int ch = tid & 63, seg = tid >> 6; const float lb = hgrn_lb(a, layer, 64 * h + ch);
    float kv[8], bc[8]; float run = 0.f;
#pragma unroll
    for (int i = 0; i < 8; ++i) { const float fp = bf2f(proj[(size_t)(row0 + seg * 8 + i) * NPROJ + C_HF + 64 * h + ch]); const float k = (1.0f - lb) / (1.0f + __expf(fp)); kv[i] = k; run += log1pf(-k); bc[i] = run; }
    SEG[seg * 64 + ch] = run;
    { const int s = tid >> 3, c8 = (tid & 7) * 8; const u32x4 v = *(const u32x4*)(proj + (size_t)(row0 + s) * NPROJ + C_HI + 64 * h + c8); st_tr8(VT, 144, c8, s * 2, v);
      *(PG8_LAS u32x4*)(ST + s * 144 + c8 * 2) = *(const u32x4*)((const bf16_t*)(a.ws + WS_UH) + (size_t)it * 4096 + s * 64 + c8);
      *(PG8_LAS u32x4*)(PS + s * 144 + c8 * 2) = (u32x4){0u, 0u, 0u, 0u}; }
    __syncthreads();
    float off = 0.f;
#pragma unroll
    for (int s2 = 0; s2 < 8; ++s2) { const float x = SEG[s2 * 64 + ch]; if (s2 < seg) off += x; }
#pragma unroll
    for (int i = 0; i < 8; ++i) { bc[i] += off; BC[(seg * 8 + i) * 65 + ch] = bc[i]; }
    __syncthreads();
    { const int ib = seg >> 1;
      const float refq = ib ? BC[(16 * ib - 1) * 65 + ch] : 0.f;
#pragma unroll
      for (int i = 0; i < 8; ++i) { const int t = seg * 8 + i; const float q = bf2f(proj[(size_t)(row0 + t) * NPROJ + C_HQ + 64 * h + ch]);
          *(PG8_LAS bf16_t*)(QH + t * 144 + ch * 2) = f2bf(q * __expf(bc[i])); *(PG8_LAS bf16_t*)(QT + t * 144 + ch * 2) = f2bf(q * __expf(bc[i] - refq)); }
      for (int ii = ib; ii < 4; ++ii) { const float ref = ii ? BC[(16 * ii - 1) * 65 + ch] : 0.f;
#pragma unroll
          for (int i = 0; i < 8; ++i) { const int s = seg * 8 + i; *(PG8_LAS bf16_t*)(KI + ii * 9216 + s * 144 + ch * 2) = f2bf(kv[i] * __expf(ref - bc[i])); } } }
    __syncthreads();
    for (int blk = wid; blk < 10; blk += 8) { int ti, si; if (blk == 0) { ti = 0; si = 0; } else if (blk < 3) { ti = 1; si = blk - 1; } else if (blk < 6) { ti = 2; si = blk - 3; } else { ti = 3; si = blk - 6; }
        f32x4 acc = (f32x4){0.f, 0.f, 0.f, 0.f}; acc = mma_k<2>(KI + ti * 9216 + si * 16 * 144, 144, QT + ti * 16 * 144, 144, fr, fq, acc);
        const int t = 16 * ti + fr, s0 = 16 * si + 4 * fq; float p[4];
#pragma unroll
        for (int j = 0; j < 4; ++j) p[j] = (s0 + j) <= t ? acc[j] : 0.f;
        u32x2 w; w.x = cvt_pk(p[0], p[1]); w.y = cvt_pk(p[2], p[3]); *(PG8_LAS u32x2*)(PS + t * 144 + s0 * 2) = w; }
    __syncthreads();
    { const int ti = wid >> 1; const int t = 16 * ti + fr;
#pragma unroll
      for (int vj = 0; vj < 2; ++vj) { const int vi = 2 * (wid & 1) + vj; f32x4 acc = (f32x4){0.f, 0.f, 0.f, 0.f};
          acc = mma_k<2>(VT + vi * 16 * 144, 144, PS + ti * 16 * 144, 144, fr, fq, acc); acc = mma_k<2>(ST + vi * 16 * 144, 144, QH + ti * 16 * 144, 144, fr, fq, acc);
          *(PG8_LAS f32x4*)(HS + t * 68 + 16 * vi + 4 * fq) = acc; } }
    __syncthreads();
    { const int t = tid >> 3, part = tid & 7; const f32x4 x0 = *(const PG8_LAS f32x4*)(HS + t * 68 + part * 8), x1 = *(const PG8_LAS f32x4*)(HS + t * 68 + part * 8 + 4);
      float q = (x0[0] * x0[0] + x0[1] * x0[1]) + (x0[2] * x0[2] + x0[3] * x0[3]) + (x1[0] * x1[0] + x1[1] * x1[1]) + (x1[2] * x1[2] + x1[3] * x1[3]);
      q += __shfl_xor(q, 1); q += __shfl_xor(q, 2); q += __shfl_xor(q, 4); const float rstd = rsqrtf(q * (1.0f / 64.0f) + 1e-6f);
      const int hc = 64 * h + part * 8; const u32x4 g = *(const u32x4*)(proj + (size_t)(row0 + t) * NPROJ + C_HG + hc); const float* nw = a.h_norm_w + layer * 256 + hc;
      const f32x4 n0 = *(const f32x4*)nw, n1 = *(const f32x4*)(nw + 4);
      u32x4 w; w.x = cvt_pk(x0[0] * rstd * n0[0] * siluf_(bflo(g.x)), x0[1] * rstd * n0[1] * siluf_(bfhi(g.x))); w.y = cvt_pk(x0[2] * rstd * n0[2] * siluf_(bflo(g.y)), x0[3] * rstd * n0[3] * siluf_(bfhi(g.y)));
      w.z = cvt_pk(x1[0] * rstd * n1[0] * siluf_(bflo(g.z)), x1[1] * rstd * n1[1] * siluf_(bfhi(g.z))); w.w = cvt_pk(x1[2] * rstd * n1[2] * siluf_(bflo(g.w)), x1[3] * rstd * n1[3] * siluf_(bfhi(g.w)));
      *(u32x4*)((bf16_t*)(a.ws + WS_XM) + (size_t)(row0 + t) * 1024 + 768 + hc) = w; }
    __syncthreads();
}

__device__ __forceinline__ void phase_m3(const Args& a, int layer, lptr lds) {
    for (int idx = blockIdx.x; idx < 3072; idx += gridDim.x) {
        if (idx < 1024) m3_qkv<0>(a, layer, idx, lds);
        else if (idx < 2048) m3_qkv<1>(a, layer, idx - 1024, lds);
        else m3_hgrn(a, layer, idx - 2048, lds);
    }
}


#ifdef DBG_NAN
__device__ __forceinline__ void scan_bf16(const void* p, size_t n, unsigned* cnt) { const unsigned short* q = (const unsigned short*)p; unsigned c = 0;
    for (size_t i = (size_t)blockIdx.x * 512 + ltid(); i < n; i += (size_t)gridDim.x * 512) c += ((q[i] & 0x7f80u) == 0x7f80u) ? 1u : 0u;
    if (c) atomicAdd(cnt, c); }
__device__ __forceinline__ void scan_f32(const void* p, size_t n, unsigned* cnt) { const unsigned* q = (const unsigned*)p; unsigned c = 0;
    for (size_t i = (size_t)blockIdx.x * 512 + ltid(); i < n; i += (size_t)gridDim.x * 512) c += ((q[i] & 0x7f800000u) == 0x7f800000u) ? 1u : 0u;
    if (c) atomicAdd(cnt, c); }
__device__ __forceinline__ void dbg_scan(const Args& a, int ph, int layer, int sub) {
    unsigned* cnt = (unsigned*)(a.ws + WS_END) + ph;
    if (sub == -1) { scan_bf16(a.ws + WS_XM, (size_t)16512 * 1024, cnt); scan_bf16(a.ws + WS_WIN, (size_t)2 * NPAD * 1024, cnt); scan_bf16(a.ws + WS_WOUT, (size_t)2 * 1024 * 1024, cnt); scan_f32(a.ws + WS_ROPE, 2049 * 96, cnt); }
    else if (sub == 0) { scan_bf16(a.ws + WS_PROJ, (size_t)16512 * NPROJ, cnt); scan_f32(a.ws + WS_GATES, 16512 * 8, cnt); }
    else if (sub == 1 && layer == 0) { unsigned* c2 = (unsigned*)(a.ws + WS_END) + 16; scan_bf16(a.ws + WS_UM, (size_t)1024 * 9216, c2 + 1); scan_bf16(a.ws + WS_UR, (size_t)1024 * 9216, c2 + 2); scan_bf16(a.ws + WS_UH, (size_t)1024 * 4096, c2 + 3);
        scan_f32(a.ws + WS_NU, 1024 * 96, c2 + 4); scan_f32(a.ws + WS_EG, 1024 * 64, c2 + 5); scan_bf16(a.ws + WS_XM + (size_t)NPR * 2048, 128 * 1024, c2 + 6);
        scan_f32(a.out + O_MC_S + (size_t)layer * 128 * 4 * 9216, (size_t)128 * 4 * 9216, c2 + 7); scan_f32(a.out + O_RET_S + (size_t)layer * 128 * 4 * 9216, (size_t)128 * 4 * 9216, c2 + 8); scan_f32(a.out + O_HG_S + (size_t)layer * 128 * 4 * 4096, (size_t)128 * 4 * 4096, c2 + 9);
        { const unsigned short* q = (const unsigned short*)(a.ws + WS_PROJ); unsigned c = 0; for (size_t i = (size_t)blockIdx.x * 512 + ltid(); i < (size_t)16512 * NPROJ; i += (size_t)gridDim.x * 512) c += ((q[i] & 0x7f80u) >= 0x4300u) ? 1u : 0u; if (c) atomicAdd(c2 + 10, c); } }
    else if (sub == 2) { scan_bf16(a.ws + WS_UM, (size_t)1024 * 9216, cnt); scan_bf16(a.ws + WS_UR, (size_t)1024 * 9216, cnt); scan_bf16(a.ws + WS_UH, (size_t)1024 * 4096, cnt);
        scan_f32(a.ws + WS_NU, 1024 * 96, cnt); scan_bf16(a.ws + WS_XM + (size_t)NPR * 2048, 128 * 1024, cnt); scan_f32(a.out + O_YS, 128 * 1024, cnt); scan_f32(a.out + O_MC_P, O_MC_S - O_MC_P, cnt); }
    else if (sub == 3) { scan_bf16(a.ws + WS_XM, (size_t)NPR * 1024, cnt); }
    else if (sub == 4) { scan_f32(a.ws + WS_PROJ, (size_t)NPR * 1024, cnt); }
    else { scan_f32(a.out + O_Y, (size_t)NPR * 1024, cnt); }
}
#endif

#ifdef DBG_G1
__device__ __forceinline__ void dbg_g1(const Args& a) {
    unsigned* mx = (unsigned*)(a.ws + WS_END) + 40; const bf16_t* proj = (const bf16_t*)(a.ws + WS_PROJ); const float* gates = (const float*)(a.ws + WS_GATES);
    for (unsigned idx = blockIdx.x * 512 + ltid(); idx < 16384u; idx += gridDim.x * 512) {
        const unsigned h1 = idx * 2654435761u, h2 = (idx ^ 0x5bd1e995u) * 2246822519u; const int r = (int)((h1 >> 8) % 16512u), c = (int)((h2 >> 8) % 4488u);
        const float* xr = r < NPR ? a.x_prompt + (size_t)r * 1024 : a.x_sample + (size_t)(r - NPR) * 1024; float dot = 0.f;
        for (int k = 0; k < 1024; ++k) dot += xr[k] * a.w_in[(size_t)k * 4488 + c];
        const int n = c < 1920 ? c : (c < 1928 ? 4480 + (c - 1920) : c - 8);
        const float val = n < 4480 ? bf2f(proj[(size_t)r * NPROJ + n]) : gates[(size_t)r * 8 + n - 4480];
        float d = fabsf(val - dot); if (!(d == d)) d = 1e30f; atomicMax(mx, __float_as_uint(d)); }
}
#endif
#define XB_TMO      128
#define XB_XCNT(j)  (256  + 64 * (j))
#define XB_XSUB(j)  (1280 + 64 * (j))
#define XB_XGEN(j)  (2304 + 64 * (j))
#define XB_TOP      3328
#define XB_TOPGEN   3392
#define XCD_BAR_WORDS 3456
#define XB_SPIN_CAP (1u << 18)
#define LAS __attribute__((address_space(3)))


__device__ __forceinline__ unsigned xb_ld(unsigned* p)              { return __hip_atomic_load(p, __ATOMIC_RELAXED, __HIP_MEMORY_SCOPE_AGENT); }
__device__ __forceinline__ unsigned xb_add(unsigned* p, unsigned v) { return __hip_atomic_fetch_add(p, v, __ATOMIC_RELAXED, __HIP_MEMORY_SCOPE_AGENT); }
__device__ __forceinline__ unsigned xb_xcc_id() { return (unsigned)__builtin_amdgcn_s_getreg((3 << 11) | 20) & 0xFu; }
#define XB_SPIN(cond, bar) do { unsigned _sp = 0; while (cond) { __builtin_amdgcn_s_sleep(1); \
    if ((++_sp & 255u) == 0u) { if (xb_ld(&(bar)[XB_TMO])) break; if (_sp > XB_SPIN_CAP) { atomicAdd(&(bar)[XB_TMO], 1u); break; } } } } while (0)

struct XcdBarrier {
    unsigned* bar; unsigned x;
    volatile LAS unsigned* st;
};

__device__ __forceinline__ XcdBarrier xcd_barrier_post(unsigned* bar, volatile LAS unsigned* st) {
    XcdBarrier b; b.bar = bar; b.x = xb_xcc_id(); b.st = st;
    if (threadIdx.x == 0) (void)xb_add(&bar[XB_XCNT(b.x)], 1u);
    return b;
}
__device__ __forceinline__ void xcd_barrier_complete(unsigned* bar, unsigned x, unsigned& nloc, unsigned& nx) {
    const unsigned G = gridDim.x * gridDim.y * gridDim.z;
    unsigned sum, cnt, mine, sp = 0u;
    for (;;) {
        sum = 0u; cnt = 0u; mine = 0u;
#pragma unroll
        for (unsigned j = 0; j < 16; ++j) { const unsigned c = xb_ld(&bar[XB_XCNT(j)]); sum += c; cnt += (c > 0u) ? 1u : 0u; mine = (j == x) ? c : mine; }
        if (sum == G) break;
        __builtin_amdgcn_s_sleep(1);
        if ((++sp & 255u) == 0u) { if (xb_ld(&bar[XB_TMO])) break; if (sp > XB_SPIN_CAP) { atomicAdd(&bar[XB_TMO], 1u); break; } }
    }
    nloc = mine > 0u ? mine : 1u; nx = cnt > 0u ? cnt : 1u;
}

__device__ __forceinline__ void xcd_barrier(const XcdBarrier& b) {
    asm volatile("s_waitcnt vmcnt(0)" ::: "memory");
    __syncthreads();
    if (threadIdx.x == 0) {
        unsigned* bar = b.bar;
        __builtin_amdgcn_s_waitcnt(0);
        unsigned nloc = b.st[0], nx = b.st[1];
        if (nloc == 0u) { xcd_barrier_complete(bar, b.x, nloc, nx); b.st[0] = nloc; b.st[1] = nx; }
        const unsigned old = xb_add(&bar[XB_XSUB(b.x)], 1u);
        const unsigned gen = old / nloc;
        if (old + 1u == (gen + 1u) * nloc) {
            __builtin_amdgcn_fence(__ATOMIC_RELEASE, "agent");
            asm volatile("s_waitcnt vmcnt(0)" ::: "memory");
            const unsigned og = xb_add(&bar[XB_TOP], 1u);
            const unsigned tg = og / nx;
            if (og + 1u == (tg + 1u) * nx) xb_add(&bar[XB_TOPGEN], 1u);
            else XB_SPIN(xb_ld(&bar[XB_TOPGEN]) == tg, bar);
            __builtin_amdgcn_fence(__ATOMIC_ACQUIRE, "agent");
            xb_add(&bar[XB_XGEN(b.x)], 1u);
            asm volatile("s_waitcnt vmcnt(0)" ::: "memory");
        } else {
            XB_SPIN(xb_ld(&bar[XB_XGEN(b.x)]) == gen, bar);
            __builtin_amdgcn_fence(__ATOMIC_ACQUIRE, "agent");
            asm volatile("s_waitcnt vmcnt(0)" ::: "memory");
        }
    }
    __syncthreads();
}


#define gsync(grid) xcd_barrier(xb)
__global__ void __launch_bounds__(512) hybrid_fwd(Args a) {
    extern __shared__ __attribute__((aligned(16))) unsigned char smem[];
    lptr lds = (lptr)smem;
    cg::grid_group grid = cg::this_grid();
    if (a.ws == nullptr) grid.sync();
    volatile LAS unsigned* xst = (volatile LAS unsigned*)(lds + 131072);
    if (threadIdx.x < 4) xst[threadIdx.x] = 0u;
    __syncthreads();
    const XcdBarrier xb = xcd_barrier_post((unsigned*)(a.ws + WS_BAR), xst);
#ifdef DBG_TA
    if (blockIdx.x == 0 && ltid() == 0) ((unsigned long long*)(a.ws + WS_END + 1024))[0] = __builtin_amdgcn_s_memrealtime();
#endif
#if defined(DBG_NAN) || defined(DBG_G1)
    if (blockIdx.x == 0 && ltid() < 64) ((unsigned*)(a.ws + WS_END))[ltid()] = 0u;
#endif
    int rep = 0; (void)rep;
#pragma nounroll
    for (int ph = 0; ph < 13; ++ph) {
        const int layer = ph > 6 ? 1 : 0; const int sub = ph == 0 ? -1 : (ph - 1) % 6;
        if (sub == -1) phase_prologue(a, lds);
        else if (sub == 0) { pg8::Gemm g; g.A = (const bf16_t*)(a.ws + WS_XM); g.Bt = (const bf16_t*)(a.ws + WS_WIN) + (size_t)layer * NPAD * 1024; g.M = NRP; g.N = NPAD; g.K = 1024;
            pg8::StaticOrder S; S.init(g.M, g.N, (int)gridDim.x, (int)blockIdx.x);
            EpiProj E; E.proj = (bf16_t*)(a.ws + WS_PROJ); E.gates = (float*)(a.ws + WS_GATES);
            pg8::gemm_phase<EpiProj, pg8::StaticOrder>(lds, g, S, E); }
        else if (sub == 1) phase_m1(a, layer, lds);
        else if (sub == 2) phase_m2(a, layer, lds);
        else if (sub == 3) phase_m3(a, layer, lds);
        else if (sub == 4) { pg8::Gemm g; g.A = (const bf16_t*)(a.ws + WS_XM); g.Bt = (const bf16_t*)(a.ws + WS_WOUT) + (size_t)layer * 1024 * 1024; g.M = NPR; g.N = 1024; g.K = 1024;
            pg8::StaticOrder S; S.init(g.M, g.N, (int)gridDim.x, (int)blockIdx.x);
            EpiOut E; E.xres = layer == 0 ? a.x_prompt : a.out + O_Y; E.pre = (float*)(a.ws + WS_PROJ);
            pg8::gemm_phase<EpiOut, pg8::StaticOrder>(lds, g, S, E); }
        else phase_ln(a, layer);
#ifdef DBG_NAN
        gsync(grid); dbg_scan(a, ph, layer, sub); gsync(grid);
#elif defined(DBG_G1)
        gsync(grid); if (ph == 1) { dbg_g1(a); gsync(grid); break; }
#elif defined(REP_MASK)
        if (ph < 12 || rep == 0) gsync(grid);
        if (rep == 0 && ((REP_MASK >> (sub + 1)) & 1)) { rep = 1; --ph; } else rep = 0;
#elif defined(DBG_TA)
        gsync(grid); if (blockIdx.x == 0 && ltid() == 0) ((unsigned long long*)(a.ws + WS_END + 1024))[ph + 1] = __builtin_amdgcn_s_memrealtime();
#else
        if (ph < 12) gsync(grid);
#endif
    }
#ifdef DBG_TA
    { const unsigned long long* ts = (const unsigned long long*)(a.ws + WS_END + 1024);
      const float tb = (float)(ts[DBG_TB + 1] - ts[DBG_TB]) * 0.01f, ta = (float)(ts[DBG_TA + 1] - ts[DBG_TA]) * 0.01f;
      gsync(grid);
      for (size_t i = (size_t)blockIdx.x * 512 + ltid(); i < O_END; i += (size_t)gridDim.x * 512) a.out[i] = i < O_YS ? 1.0e3f * tb : 0.f;
      gsync(grid);
      if (blockIdx.x == 0 && ltid() == 0) a.out[O_MC_S] = 1.0e4f * ta; }
#endif
#ifdef DBG_G1
    for (size_t i = (size_t)blockIdx.x * 512 + ltid(); i < O_END; i += (size_t)gridDim.x * 512) a.out[i] = 0.f;
    gsync(grid);
    if (blockIdx.x == 0 && ltid() == 0) a.out[0] = 1.0e6f * __uint_as_float(((const unsigned*)(a.ws + WS_END))[40]);
#endif
#ifdef DBG_NAN
    for (size_t i = (size_t)blockIdx.x * 512 + ltid(); i < O_END; i += (size_t)gridDim.x * 512) a.out[i] = 0.f;
    gsync(grid);
    if (blockIdx.x == 0 && ltid() == 0) { const unsigned* cnt = (const unsigned*)(a.ws + WS_END); a.out[0] = 1.0e5f * (float)((cnt[17] ? 1 : 0) + (cnt[18] ? 2 : 0) + (cnt[19] ? 4 : 0)) + 1.0e4f * (float)((cnt[20] ? 1 : 0) + (cnt[21] ? 2 : 0) + (cnt[22] ? 4 : 0)); }
#endif
}

extern "C" void kernel_launch(void* const* d_in, const int* in_sizes, int n_in, void* d_out, int out_size, void* d_ws, size_t ws_size, hipStream_t stream) {
    static int grid = 0;
    constexpr int LDSB = 131072 + 64;
    if (!grid) {
        int dev = 0, cus = 0, per_cu = 0;
        (void)hipGetDevice(&dev);
        (void)hipDeviceGetAttribute(&cus, hipDeviceAttributeMultiprocessorCount, dev);
        (void)hipFuncSetAttribute((const void*)hybrid_fwd, hipFuncAttributeMaxDynamicSharedMemorySize, LDSB);
        (void)hipOccupancyMaxActiveBlocksPerMultiprocessor(&per_cu, (const void*)hybrid_fwd, 512, LDSB);
        if (per_cu < 1) per_cu = 1;
        grid = cus * per_cu;
        if (n_in != 19 || out_size != (int)O_END || ws_size < WS_END) fprintf(stderr, "kernel_launch: unexpected sizes n_in %d out %d ws %zu\n", n_in, out_size, ws_size);
        fprintf(stderr, "kernel_launch: grid %d (cus %d x %d)\n", grid, cus, per_cu);
    }
    (void)hipMemsetAsync((unsigned char*)d_ws + WS_BAR, 0, XCD_BAR_WORDS * 4, stream);
    Args a{};
    a.x_prompt = (const float*)d_in[0]; a.x_sample = (const float*)d_in[1]; a.st_C = (const float*)d_in[2]; a.st_n = (const float*)d_in[3]; a.st_m = (const float*)d_in[4];
    a.st_conv = (const float*)d_in[5]; a.st_ret = (const float*)d_in[6]; a.st_hgrn = (const float*)d_in[7]; a.w_in = (const float*)d_in[8]; a.conv_w = (const float*)d_in[9];
    a.conv_b = (const float*)d_in[10]; a.b_mgate = (const float*)d_in[11]; a.m_norm_w = (const float*)d_in[12]; a.r_norm_w = (const float*)d_in[13]; a.h_norm_w = (const float*)d_in[14];
    a.hgrn_lb = (const float*)d_in[15]; a.w_out = (const float*)d_in[16]; a.ln_g = (const float*)d_in[17]; a.ln_b = (const float*)d_in[18];
    a.out = (float*)d_out; a.ws = (unsigned char*)d_ws;
    void* args[] = {&a};
    hipError_t e = hipLaunchCooperativeKernel((const void*)hybrid_fwd, dim3(grid), dim3(512), args, LDSB, stream);
    if (e != hipSuccess) fprintf(stderr, "cooperative launch failed: %s (grid %d)\n", hipGetErrorString(e), grid);
}
```
